# Optimizing an MI355X kernel written in HIP

```python
import jax
import jax.numpy as jnp
from jax import lax
import numpy as np

D_MODEL = 1024
BATCH = 4
SEQ = 4096
DEPTH = 4

GRID_W = 64
CTX_LEN = 256
HEAD_DIM = 64
GROUP_WIDTH = D_MODEL // 4
N_HEADS_A = GROUP_WIDTH // HEAD_DIM
N_HEADS_B = GROUP_WIDTH // HEAD_DIM
N_HEADS_C = GROUP_WIDTH // HEAD_DIM
N_KV_C = N_HEADS_C // 2
KV_WIDTH_C = N_KV_C * HEAD_DIM
DECAY_RANK = GROUP_WIDTH // 8
ICLR_RANK = GROUP_WIDTH // 8
GATE_RANK = GROUP_WIDTH // 4
RWKV_GN_EPS = 1e-5 * HEAD_DIM
NA_ROWS = 8
NA_COLS = 16
Q_BLOCK = 128
ROPE_THETA = 10000.0
POOL_WINDOWS = (2, 4, 8, 16)
POOL_GROUP = GROUP_WIDTH // 4
D_FF = 4 * D_MODEL
NORM_EPS = 1e-6
N_MOD = 6
PROJ_SPLITS = (GROUP_WIDTH, GROUP_WIDTH, GROUP_WIDTH, DECAY_RANK, DECAY_RANK, ICLR_RANK, ICLR_RANK, GATE_RANK,
               GROUP_WIDTH, GROUP_WIDTH, GROUP_WIDTH,
               GROUP_WIDTH, KV_WIDTH_C, KV_WIDTH_C,
               GROUP_WIDTH)
D_IN = sum(PROJ_SPLITS)
SLICE_A = slice(0, 8)
SLICE_B = slice(8, 11)
SLICE_C = slice(11, 14)
INDEX_D = 14

kernel_name = 'hybrid_rwkv7_natten_gqa_pool_dit_trunk'


def rms_norm(x, gain):
    xf = x.astype(jnp.float32)
    y = xf * lax.rsqrt(jnp.mean(xf * xf, axis=-1, keepdims=True) + NORM_EPS)
    return (y * gain.astype(jnp.float32)).astype(x.dtype)


def modulate(h, shift, scale):
    return h * (1.0 + scale) + shift


def split_projection(p):
    points = [int(s) for s in np.cumsum(PROJ_SPLITS)[:-1]]
    return jnp.split(p, points, axis=-1)


def heads_first(t, n_heads):
    b, l, _ = t.shape
    return t.reshape(b, l, n_heads, HEAD_DIM).transpose(0, 2, 1, 3)


def heads_last(t):
    b, h, l, d = t.shape
    return t.transpose(0, 2, 1, 3).reshape(b, l, h * d)


def axial_rope_tables(n_tokens):
    t = jnp.arange(n_tokens)
    row = (t // GRID_W).astype(jnp.float32)
    col = (t % GRID_W).astype(jnp.float32)
    n_freq = HEAD_DIM // 4
    inv_freq = ROPE_THETA ** (-jnp.arange(n_freq, dtype=jnp.float32) / n_freq)
    ang = jnp.concatenate([row[:, None] * inv_freq, col[:, None] * inv_freq], axis=-1)
    return jnp.cos(ang), jnp.sin(ang)


def apply_rope(x, cos, sin):
    xf = x.astype(jnp.float32)
    x1, x2 = jnp.split(xf, 2, axis=-1)
    return jnp.concatenate([x1 * cos - x2 * sin, x1 * sin + x2 * cos], axis=-1).astype(x.dtype)


def softmax_attention(q, k, v):
    s = jnp.einsum('bhqd,bhkd->bhqk', q, k).astype(jnp.float32) * HEAD_DIM ** -0.5
    p = jax.nn.softmax(s, axis=-1).astype(v.dtype)
    return jnp.einsum('bhqk,bhkd->bhqd', p, v)


def gqa_block_sweep(q, k, v):
    b, hq, lq, d = q.shape
    hkv = k.shape[1]
    groups = hq // hkv
    n_blocks = lq // Q_BLOCK
    qb = jnp.moveaxis(q.reshape(b, hkv, groups, n_blocks, Q_BLOCK, d), 3, 0)

    def one_block(q_blk):
        s = jnp.einsum('bkgqd,bksd->bkgqs', q_blk, k).astype(jnp.float32) * d ** -0.5
        p = jax.nn.softmax(s, axis=-1).astype(v.dtype)
        return jnp.einsum('bkgqs,bksd->bkgqd', p, v)

    out = lax.map(one_block, qb)
    return jnp.moveaxis(out, 0, 3).reshape(b, hq, lq, d)


def rwkv_heads(t):
    b, l, _ = t.shape
    return t.astype(jnp.float32).reshape(b, l, N_HEADS_A, HEAD_DIM)


def rwkv_direction_terms(k, w_lo, a_lo, w0, w2, a0, a2, k_k, k_a):
    kf = k.astype(jnp.float32)
    w = -jax.nn.softplus(-(w0 + jnp.tanh(w_lo) @ w2).astype(jnp.float32)) - 0.5
    decay = jnp.exp(-jnp.exp(w))
    a = jax.nn.sigmoid((a0 + a_lo @ a2).astype(jnp.float32))
    kk = rwkv_heads(kf * k_k)
    kk = kk / jnp.maximum(jnp.sqrt(jnp.sum(kk * kk, axis=-1, keepdims=True)), 1e-12)
    k_mod = kf * (1.0 + (a - 1.0) * k_a)
    return rwkv_heads(decay), kk, kk * rwkv_heads(a), rwkv_heads(k_mod)


def wkv7_scan(state0, r, v, decay, kk, b, k, reverse, with_output):
    to_time = lambda t: jnp.moveaxis(t, 1, 0)

    def update(s, w_t, kk_t, b_t, k_t, v_t):
        sa = jnp.einsum('bhvk,bhk->bhv', s, kk_t)
        return s * w_t[:, :, None, :] - sa[..., None] * b_t[:, :, None, :] + v_t[..., None] * k_t[:, :, None, :]

    if with_output:
        def step(s, xs):
            r_t, w_t, kk_t, b_t, k_t, v_t = xs
            s = update(s, w_t, kk_t, b_t, k_t, v_t)
            return s, jnp.einsum('bhvk,bhk->bhv', s, r_t)
        s_final, ys = lax.scan(step, state0, tuple(map(to_time, (r, decay, kk, b, k, v))), reverse=reverse)
        return s_final, jnp.moveaxis(ys, 0, 1)

    def step_state(s, xs):
        return update(s, *xs), None
    s_final, _ = lax.scan(step_state, state0, tuple(map(to_time, (decay, kk, b, k, v))), reverse=reverse)
    return s_final, None


def rwkv_readout(y, r, v, k_f, k_b, g_lo, r_k, g2, gn_w, gn_b):
    mu = jnp.mean(y, axis=-1, keepdims=True)
    var = jnp.mean(jnp.square(y - mu), axis=-1, keepdims=True)
    yn = ((y - mu) * lax.rsqrt(var + RWKV_GN_EPS)).reshape(y.shape[0], y.shape[1], GROUP_WIDTH) * gn_w + gn_b
    bonus = jnp.sum(r * (k_f + k_b) * r_k, axis=-1, keepdims=True) * v
    gate = jax.nn.sigmoid(g_lo) @ g2
    return (yn + bonus.reshape(yn.shape)) * gate


def rwkv_mixer(p_lat, p_ctx, w0, w2, a0, a2, k_k, k_a, r_k, g2, gn_w, gn_b, need_ctx_out):
    def terms(p):
        r, k, v, w_f, w_b, a_f, a_b, g = p
        fwd = rwkv_direction_terms(k, w_f, a_f, w0[0], w2[0], a0[0], a2[0], k_k, k_a)
        bwd = rwkv_direction_terms(k, w_b, a_b, w0[1], w2[1], a0[1], a2[1], k_k, k_a)
        return rwkv_heads(r), rwkv_heads(v), fwd, bwd, g

    r_c, v_c, fwd_c, bwd_c, g_c = terms(p_ctx)
    zero = jnp.zeros((r_c.shape[0], N_HEADS_A, HEAD_DIM, HEAD_DIM), jnp.float32)
    s_f, y_cf = wkv7_scan(zero, r_c, v_c, *fwd_c, reverse=False, with_output=need_ctx_out)
    s_b, y_cb = wkv7_scan(zero, r_c, v_c, *bwd_c, reverse=True, with_output=need_ctx_out)
    r_l, v_l, fwd_l, bwd_l, g_l = terms(p_lat)
    _, y_lf = wkv7_scan(s_f, r_l, v_l, *fwd_l, reverse=False, with_output=True)
    _, y_lb = wkv7_scan(s_b, r_l, v_l, *bwd_l, reverse=True, with_output=True)
    out_l = rwkv_readout(y_lf + y_lb, r_l, v_l, fwd_l[3], bwd_l[3], g_l, r_k, g2, gn_w, gn_b)
    out_c = None
    if need_ctx_out:
        out_c = rwkv_readout(y_cf + y_cb, r_c, v_c, fwd_c[3], bwd_c[3], g_c, r_k, g2, gn_w, gn_b)
    return out_l, out_c


def neighbourhood_mixer(p_lat, p_ctx, rpb, need_ctx_out):
    q, k, v = p_lat
    q_c, k_c, v_c = p_ctx
    bsz, n_lat, _ = q.shape
    rows = n_lat // GRID_W
    kh = min(NA_ROWS, rows)

    def grid(t):
        return t.reshape(bsz, rows, GRID_W, N_HEADS_B, HEAD_DIM).transpose(0, 3, 1, 2, 4)

    qg, kg, vg = grid(q), grid(k), grid(v)
    r_idx = jnp.arange(rows)
    row_start = jnp.clip(r_idx - kh // 2, 0, rows - kh)
    row_idx = row_start[:, None] + jnp.arange(kh)
    k_band = kg[:, :, row_idx]
    v_band = vg[:, :, row_idx]
    col = jnp.arange(GRID_W)
    col_start = jnp.clip(col - NA_COLS // 2, 0, GRID_W - NA_COLS)
    in_win = (col[None, :] >= col_start[:, None]) & (col[None, :] < col_start[:, None] + NA_COLS)
    col_off = jnp.clip(col[None, :] - col[:, None], -(NA_COLS - 1), NA_COLS - 1) + NA_COLS - 1
    row_off = row_idx - r_idx[:, None] + NA_ROWS - 1
    bias = rpb[:, row_off[:, None, :, None], col_off[None, :, None, :]].astype(jnp.float32)
    bias = jnp.where(in_win[None, None, :, None, :], bias, -jnp.inf)
    scale = HEAD_DIM ** -0.5
    s_loc = jnp.einsum('bhrqd,bhrikd->bhrqik', qg, k_band).astype(jnp.float32) * scale + bias[None]
    kcg, vcg = heads_first(k_c, N_HEADS_B), heads_first(v_c, N_HEADS_B)
    s_ctx = jnp.einsum('bhrqd,bhcd->bhrqc', qg, kcg).astype(jnp.float32) * scale
    n_loc = kh * GRID_W
    s = jnp.concatenate([s_loc.reshape(bsz, N_HEADS_B, rows, GRID_W, n_loc), s_ctx], axis=-1)
    p = jax.nn.softmax(s, axis=-1).astype(v.dtype)
    p_loc = p[..., :n_loc].reshape(bsz, N_HEADS_B, rows, GRID_W, kh, GRID_W)
    o = (jnp.einsum('bhrqik,bhrikd->bhrqd', p_loc, v_band)
         + jnp.einsum('bhrqc,bhcd->bhrqd', p[..., n_loc:], vcg))
    out_l = o.transpose(0, 2, 3, 1, 4).reshape(bsz, n_lat, GROUP_WIDTH)
    out_c = None
    if need_ctx_out:
        out_c = heads_last(softmax_attention(heads_first(q_c, N_HEADS_B), kcg, vcg))
    return out_l, out_c


def gqa_mixer(p_lat, p_ctx, q_gain, k_gain, cos, sin, need_ctx_out):
    q_l, k_l, v_l = p_lat
    q_c, k_c, v_c = p_ctx
    ql = apply_rope(rms_norm(heads_first(q_l, N_HEADS_C), q_gain), cos, sin)
    kl = apply_rope(rms_norm(heads_first(k_l, N_KV_C), k_gain), cos, sin)
    kc = rms_norm(heads_first(k_c, N_KV_C), k_gain)
    vc = heads_first(v_c, N_KV_C)
    k_all = jnp.concatenate([kc, kl], axis=2)
    v_all = jnp.concatenate([vc, heads_first(v_l, N_KV_C)], axis=2)
    out_l = heads_last(gqa_block_sweep(ql, k_all, v_all))
    out_c = None
    if need_ctx_out:
        qc = rms_norm(heads_first(q_c, N_HEADS_C), q_gain)
        out_c = heads_last(gqa_block_sweep(qc, kc, vc))
    return out_l, out_c


def centred_window_mean(x, window):
    n = x.shape[1]
    cs = jnp.pad(jnp.cumsum(x.astype(jnp.float32), axis=1), ((0, 0), (1, 0), (0, 0)))
    t = jnp.arange(n)
    lo = jnp.clip(t - window // 2, 0, n)
    hi = jnp.clip(t - window // 2 + window, 0, n)
    return (cs[:, hi] - cs[:, lo]) / (hi - lo).astype(jnp.float32)[None, :, None]


def pool_mixer(p, pool_w, pool_scale):
    groups = jnp.split(p, len(POOL_WINDOWS), axis=-1)
    outs = [jnp.einsum('blc,cd->bld', centred_window_mean(g, w) - g.astype(jnp.float32), pool_w[j])
            for j, (g, w) in enumerate(zip(groups, POOL_WINDOWS))]
    return jnp.concatenate(outs, axis=-1) * pool_scale


def squared_relu_mlp(h, w1, w2):
    return jnp.square(jax.nn.relu(h @ w1)) @ w2


def setup_inputs(seed: int = 0) -> dict:
    key = jax.random.key(seed)
    ks = jax.random.split(key, 32)
    nrm = jax.random.normal
    f32 = jnp.float32
    d = D_MODEL
    return {
        'x': nrm(ks[0], (BATCH, SEQ, d), f32),
        'c': nrm(ks[1], (BATCH, d), f32),
        'ctx': nrm(ks[2], (BATCH, CTX_LEN, d), f32),
        'c_ctx': nrm(ks[3], (d,), f32),
        'ada_w': nrm(ks[4], (DEPTH, d, N_MOD * d), f32) * (0.5 * d ** -0.5),
        'ada_b': nrm(ks[5], (DEPTH, N_MOD * d), f32) * 0.01,
        'norm1_g': 1.0 + 0.02 * nrm(ks[6], (DEPTH, d), f32),
        'norm2_g': 1.0 + 0.02 * nrm(ks[7], (DEPTH, d), f32),
        'w_in': nrm(ks[8], (DEPTH, d, D_IN), f32) * d ** -0.5,
        'w_out': nrm(ks[9], (DEPTH, d, d), f32) * d ** -0.5,
        'rwkv_w0': jax.random.uniform(ks[10], (DEPTH, 2, GROUP_WIDTH), f32, -5.0, 1.0),
        'rwkv_w2': nrm(ks[11], (DEPTH, 2, DECAY_RANK, GROUP_WIDTH), f32) * 0.1,
        'rwkv_a0': nrm(ks[12], (DEPTH, 2, GROUP_WIDTH), f32) * 0.1,
        'rwkv_a2': nrm(ks[13], (DEPTH, 2, ICLR_RANK, GROUP_WIDTH), f32) * 0.1,
        'rwkv_k_k': 0.85 + 0.02 * nrm(ks[14], (DEPTH, GROUP_WIDTH), f32),
        'rwkv_k_a': 1.0 + 0.02 * nrm(ks[15], (DEPTH, GROUP_WIDTH), f32),
        'rwkv_r_k': nrm(ks[16], (DEPTH, N_HEADS_A, HEAD_DIM), f32) * 0.1,
        'rwkv_g2': nrm(ks[17], (DEPTH, GATE_RANK, GROUP_WIDTH), f32) * GATE_RANK ** -0.5,
        'rwkv_gn_w': 1.0 + 0.02 * nrm(ks[18], (DEPTH, GROUP_WIDTH), f32),
        'rwkv_gn_b': 0.01 * nrm(ks[19], (DEPTH, GROUP_WIDTH), f32),
        'na_rpb': 0.02 * nrm(ks[20], (DEPTH, N_HEADS_B, 2 * NA_ROWS - 1, 2 * NA_COLS - 1), f32),
        'gqa_q_gain': 1.0 + 0.02 * nrm(ks[21], (DEPTH, HEAD_DIM), f32),
        'gqa_k_gain': 1.0 + 0.02 * nrm(ks[22], (DEPTH, HEAD_DIM), f32),
        'pool_w': nrm(ks[23], (DEPTH, len(POOL_WINDOWS), POOL_GROUP, POOL_GROUP), f32) * POOL_GROUP ** -0.5,
        'pool_scale': 1.0 + 0.02 * nrm(ks[24], (DEPTH, GROUP_WIDTH), f32),
        'mlp_w1': nrm(ks[25], (DEPTH, d, D_FF), f32) * d ** -0.5,
        'mlp_w2': nrm(ks[26], (DEPTH, D_FF, d), f32) * D_FF ** -0.5,
        'final_g': 1.0 + 0.02 * nrm(ks[27], (d,), f32),
    }


def reference(x, c, ctx, c_ctx, ada_w, ada_b, norm1_g, norm2_g, w_in, w_out,
              rwkv_w0, rwkv_w2, rwkv_a0, rwkv_a2, rwkv_k_k, rwkv_k_a, rwkv_r_k, rwkv_g2,
              rwkv_gn_w, rwkv_gn_b, na_rpb, gqa_q_gain, gqa_k_gain, pool_w, pool_scale,
              mlp_w1, mlp_w2, final_g):
    bsz, n_lat, _ = x.shape
    cos, sin = axial_rope_tables(n_lat)
    silu_c = jax.nn.silu(c.astype(jnp.float32))
    silu_c_ctx = jax.nn.silu(c_ctx.astype(jnp.float32))
    xc = ctx
    for i in range(DEPTH):
        need_ctx_out = i < DEPTH - 1
        mod_l = (silu_c @ ada_w[i] + ada_b[i]).reshape(bsz, N_MOD, 1, D_MODEL).astype(x.dtype)
        mod_c = (silu_c_ctx @ ada_w[i] + ada_b[i]).reshape(N_MOD, D_MODEL).astype(x.dtype)

        h = modulate(rms_norm(x, norm1_g[i]), mod_l[:, 0], mod_l[:, 1])
        hc = modulate(rms_norm(xc, norm1_g[i]), mod_c[0], mod_c[1])
        p_lat = split_projection(h @ w_in[i])
        p_ctx = split_projection(hc @ w_in[i])
        a_l, a_c = rwkv_mixer(p_lat[SLICE_A], p_ctx[SLICE_A], rwkv_w0[i], rwkv_w2[i], rwkv_a0[i], rwkv_a2[i],
                              rwkv_k_k[i], rwkv_k_a[i], rwkv_r_k[i], rwkv_g2[i], rwkv_gn_w[i], rwkv_gn_b[i],
                              need_ctx_out)
        b_l, b_c = neighbourhood_mixer(p_lat[SLICE_B], p_ctx[SLICE_B], na_rpb[i], need_ctx_out)
        c_l, c_c = gqa_mixer(p_lat[SLICE_C], p_ctx[SLICE_C], gqa_q_gain[i], gqa_k_gain[i], cos, sin, need_ctx_out)
        d_l = pool_mixer(p_lat[INDEX_D], pool_w[i], pool_scale[i])
        mix_l = jnp.concatenate([a_l.astype(x.dtype), b_l.astype(x.dtype), c_l.astype(x.dtype),
                                 d_l.astype(x.dtype)], axis=-1)
        x = x + mod_l[:, 2] * (mix_l @ w_out[i])

        h2 = modulate(rms_norm(x, norm2_g[i]), mod_l[:, 3], mod_l[:, 4])
        x = x + mod_l[:, 5] * squared_relu_mlp(h2, mlp_w1[i], mlp_w2[i])

        if need_ctx_out:
            d_c = pool_mixer(p_ctx[INDEX_D], pool_w[i], pool_scale[i])
            mix_c = jnp.concatenate([a_c.astype(xc.dtype), b_c.astype(xc.dtype), c_c.astype(xc.dtype),
                                     d_c.astype(xc.dtype)], axis=-1)
            xc = xc + mod_c[2] * (mix_c @ w_out[i])
            h2c = modulate(rms_norm(xc, norm2_g[i]), mod_c[3], mod_c[4])
            xc = xc + mod_c[5] * squared_relu_mlp(h2c, mlp_w1[i], mlp_w2[i])
    return rms_norm(x, final_g)
```

```cpp
#include <hip/hip_runtime.h>
#include <hip/hip_cooperative_groups.h>
#include <cstdio>
namespace cg = cooperative_groups;

#ifndef KPL
#define KPL 4
#endif

#define DI __device__ __forceinline__
typedef unsigned short u16;
typedef short bf16x8 __attribute__((ext_vector_type(8)));
typedef float f32x16 __attribute__((ext_vector_type(16)));
typedef unsigned u32x4 __attribute__((ext_vector_type(4)));
typedef __bf16 bf16x2_t __attribute__((ext_vector_type(2)));
typedef float f32x2_t __attribute__((ext_vector_type(2)));

constexpr int NB = 4, SEQ = 4096, DM = 1024, DEPTH = 4, CTXL = 256;
constexpr int NLAT = NB * SEQ, NCTX = NB * CTXL, NTOK = NLAT + NCTX, SALL = SEQ + CTXL;
constexpr int DIN = 2496, DINP = 2560, PAW = 960, PBW = 1536, DFF = 4096;
constexpr float QSCALE = 0.125f * 1.4426950408889634f;
constexpr float LOG2E = 1.4426950408889634f;
constexpr int SMEM_BYTES = 65536;
constexpr size_t WSET = (size_t)DINP * DM + (size_t)DM * DM + 2 * (size_t)DFF * DM;

struct Params {
  const float *x, *c, *ctx, *c_ctx, *ada_w, *ada_b, *norm1_g, *norm2_g, *w_in, *w_out;
  const float *rw_w0, *rw_w2, *rw_a0, *rw_a2, *rw_kk, *rw_ka, *rw_rk, *rw_g2, *rw_gnw, *rw_gnb;
  const float *na_rpb, *q_gain, *k_gain, *pool_w, *pool_scale, *mlp_w1, *mlp_w2, *final_g;
  float *out;
  float *mod, *rope, *xc, *pa, *decf, *decb, *af, *ab, *kk, *bon, *yf, *yb;
  u16 *hm, *win, *wout, *w1, *w2, *pb, *u, *qb, *kb, *vtb, *qc, *kc, *vtc;
  unsigned* bar;
};

DI unsigned pack2(float a, float b) {
  f32x2_t v = {a, b};
  bf16x2_t r = __builtin_convertvector(v, bf16x2_t);
  return __builtin_bit_cast(unsigned, r);
}
DI float bf2f(u16 v) { return __uint_as_float(((unsigned)v) << 16); }
DI float bflo(unsigned v) { return __uint_as_float(v << 16); }
DI float bfhi(unsigned v) { return __uint_as_float(v & 0xffff0000u); }
template <int CTRL> DI float dpp_add(float x) {
  int y = __builtin_amdgcn_update_dpp(0, __builtin_bit_cast(int, x), CTRL, 0xf, 0xf, true);
  return x + __builtin_bit_cast(float, y);
}
DI float wave_sum(float v) {
  v = dpp_add<0xB1>(v);
  v = dpp_add<0x4E>(v);
  v = dpp_add<0x141>(v);
  v = dpp_add<0x140>(v);
  const int iv = __builtin_bit_cast(int, v);
  const float s0 = __builtin_bit_cast(float, __builtin_amdgcn_readlane(iv, 0));
  const float s1 = __builtin_bit_cast(float, __builtin_amdgcn_readlane(iv, 16));
  const float s2 = __builtin_bit_cast(float, __builtin_amdgcn_readlane(iv, 32));
  const float s3 = __builtin_bit_cast(float, __builtin_amdgcn_readlane(iv, 48));
  return (s0 + s1) + (s2 + s3);
}
template <class T> DI T* launder(T* q) { asm volatile("" : "+v"(q)); return q; }
DI int TID() { int t = threadIdx.x; asm volatile("" : "+v"(t)); return t; }
DI int modrow(int m) { return m < NLAT ? (m >> 12) : 4; }


#define XB_TMO      128
#define XB_XCNT(j)  (256  + 64 * (j))
#define XB_XSUB(j)  (1280 + 64 * (j))
#define XB_XGEN(j)  (2304 + 64 * (j))
#define XB_TOP      3328
#define XB_TOPGEN   3392
#define XCD_BAR_WORDS 3456
#define XB_SPIN_CAP (1u << 18)
#define LAS __attribute__((address_space(3)))
DI unsigned xb_ld(unsigned* p)              { return __hip_atomic_load(p, __ATOMIC_RELAXED, __HIP_MEMORY_SCOPE_AGENT); }
DI unsigned xb_add(unsigned* p, unsigned v) { return __hip_atomic_fetch_add(p, v, __ATOMIC_RELAXED, __HIP_MEMORY_SCOPE_AGENT); }
DI unsigned xb_xcc_id() { return (unsigned)__builtin_amdgcn_s_getreg((3 << 11) | 20) & 0xFu; }
#define XB_SPIN(cond, bar) do { unsigned _sp = 0; while (cond) { __builtin_amdgcn_s_sleep(1); \
    if ((++_sp & 255u) == 0u) { if (xb_ld(&(bar)[XB_TMO])) break; if (_sp > XB_SPIN_CAP) { atomicAdd(&(bar)[XB_TMO], 1u); break; } } } } while (0)
struct XcdBarrier { unsigned* bar; unsigned x; volatile LAS unsigned* st; };
DI XcdBarrier xcd_barrier_post(unsigned* bar, volatile LAS unsigned* st) {
  XcdBarrier b; b.bar = bar; b.x = xb_xcc_id(); b.st = st;
  if (threadIdx.x == 0) (void)xb_add(&bar[XB_XCNT(b.x)], 1u);
  return b;
}
DI void xcd_barrier_complete(unsigned* bar, unsigned x, unsigned& nloc, unsigned& nx) {
  const unsigned G = gridDim.x * gridDim.y * gridDim.z;
  unsigned sum, cnt, mine, sp = 0u;
  for (;;) {
    sum = 0u; cnt = 0u; mine = 0u;
#pragma unroll
    for (unsigned j = 0; j < 16; ++j) { const unsigned c = xb_ld(&bar[XB_XCNT(j)]); sum += c; cnt += (c > 0u) ? 1u : 0u; mine = (j == x) ? c : mine; }
    if (sum == G) break;
    __builtin_amdgcn_s_sleep(1);
    if ((++sp & 255u) == 0u) { if (xb_ld(&bar[XB_TMO])) break; if (sp > XB_SPIN_CAP) { atomicAdd(&bar[XB_TMO], 1u); break; } }
  }
  nloc = mine > 0u ? mine : 1u; nx = cnt > 0u ? cnt : 1u;
}
DI void xcd_barrier(const XcdBarrier& b) {
  asm volatile("s_waitcnt vmcnt(0)" ::: "memory");
  __syncthreads();
  if (threadIdx.x == 0) {
    unsigned* bar = b.bar;
    __builtin_amdgcn_s_waitcnt(0);
    unsigned nloc = b.st[0], nx = b.st[1];
    if (nloc == 0u) { xcd_barrier_complete(bar, b.x, nloc, nx); b.st[0] = nloc; b.st[1] = nx; }
    const unsigned old = xb_add(&bar[XB_XSUB(b.x)], 1u);
    const unsigned gen = old / nloc;
    if (old + 1u == (gen + 1u) * nloc) {
      __builtin_amdgcn_fence(__ATOMIC_RELEASE, "agent");
      asm volatile("s_waitcnt vmcnt(0)" ::: "memory");
      const unsigned og = xb_add(&bar[XB_TOP], 1u);
      const unsigned tg = og / nx;
      if (og + 1u == (tg + 1u) * nx) xb_add(&bar[XB_TOPGEN], 1u);
      else XB_SPIN(xb_ld(&bar[XB_TOPGEN]) == tg, bar);
      __builtin_amdgcn_fence(__ATOMIC_ACQUIRE, "agent");
      xb_add(&bar[XB_XGEN(b.x)], 1u);
      asm volatile("s_waitcnt vmcnt(0)" ::: "memory");
    } else {
      XB_SPIN(xb_ld(&bar[XB_XGEN(b.x)]) == gen, bar);
      __builtin_amdgcn_fence(__ATOMIC_ACQUIRE, "agent");
      asm volatile("s_waitcnt vmcnt(0)" ::: "memory");
    }
  }
  __syncthreads();
}

DI void setup_tile(const Params& p, int t, char* smem) {
  const int tid = TID();
  if (t < 384) {
    const int layer = t / 96, jt = t % 96;
    float* s = (float*)smem;
    for (int i = tid; i < 5 * 1024; i += 256) {
      int r = i >> 10, k = i & 1023;
      float v = (r < 4) ? p.c[r * 1024 + k] : p.c_ctx[k];
      s[i] = v / (1.f + expf(-v));
    }
    __syncthreads();
    const int jl = tid & 63, kg = tid >> 6;
    const int j = jt * 64 + jl;
    const float* w = p.ada_w + (size_t)layer * 1024 * 6144 + j;
    float acc[5] = {0.f, 0.f, 0.f, 0.f, 0.f};
#pragma unroll 32
    for (int k = kg * 256; k < kg * 256 + 256; k += 4) {
      const float w0 = w[(size_t)k * 6144], w1 = w[(size_t)(k + 1) * 6144], w2 = w[(size_t)(k + 2) * 6144], w3 = w[(size_t)(k + 3) * 6144];
#pragma unroll
      for (int r = 0; r < 5; ++r) {
        const float4 sv = *(const float4*)(s + r * 1024 + k);
        acc[r] += sv.x * w0 + sv.y * w1 + sv.z * w2 + sv.w * w3;
      }
    }
    float* red = s + 5 * 1024;
#pragma unroll
    for (int r = 0; r < 5; ++r) red[(kg * 5 + r) * 64 + jl] = acc[r];
    __syncthreads();
    if (tid < 64) {
#pragma unroll
      for (int r = 0; r < 5; ++r) {
        float v = red[(0 * 5 + r) * 64 + tid] + red[(1 * 5 + r) * 64 + tid] + red[(2 * 5 + r) * 64 + tid] + red[(3 * 5 + r) * 64 + tid];
        p.mod[(size_t)(layer * 5 + r) * 6144 + j] = v + p.ada_b[layer * 6144 + j];
      }
    }
    __syncthreads();
  } else {
    for (int i = tid; i < 1024; i += 256) {
      int pos = i >> 4, f = i & 15;
      float invf = exp2f(-(float)f * (13.287712379549449f / 16.f));
      float ang = (float)pos * invf;
      float kf = rintf(ang * 0.15915494309189535f);
      float r = fmaf(-kf, 6.28125f, ang);
      r = fmaf(-kf, 1.9353071795864769e-3f, r);
      p.rope[i * 2] = cosf(r);
      p.rope[i * 2 + 1] = sinf(r);
    }
  }
}

DI void convert_tile(const float* src, u16* dst, int K, int N, int kt, int nt, char* smem) {
  const int tid = TID();
  float* tile = (float*)smem;
  const int k0 = kt * 64, n0 = nt * 64;
#pragma unroll
  for (int j = 0; j < 4; ++j) {
    int kr = (tid >> 4) + 16 * j, nc = (tid & 15) * 4;
    float4 v = make_float4(0.f, 0.f, 0.f, 0.f);
    if (n0 + nc < N) v = *(const float4*)(src + (size_t)(k0 + kr) * N + n0 + nc);
    tile[kr * 65 + nc + 0] = v.x; tile[kr * 65 + nc + 1] = v.y; tile[kr * 65 + nc + 2] = v.z; tile[kr * 65 + nc + 3] = v.w;
  }
  __syncthreads();
#pragma unroll
  for (int j = 0; j < 2; ++j) {
    int n = (tid >> 3) + 32 * j, k8 = (tid & 7) * 8;
    uint4 o;
    o.x = pack2(tile[(k8 + 0) * 65 + n], tile[(k8 + 1) * 65 + n]);
    o.y = pack2(tile[(k8 + 2) * 65 + n], tile[(k8 + 3) * 65 + n]);
    o.z = pack2(tile[(k8 + 4) * 65 + n], tile[(k8 + 5) * 65 + n]);
    o.w = pack2(tile[(k8 + 6) * 65 + n], tile[(k8 + 7) * 65 + n]);
    *(uint4*)(dst + (size_t)(n0 + n) * K + k0 + k8) = o;
  }
  __syncthreads();
}

DI const float* xrow_ptr(const Params& p, int layer, int m) {
  if (layer == 0) return m < NLAT ? p.x + (size_t)m * DM : p.ctx + (size_t)(m - NLAT) * DM;
  return m < NLAT ? p.out + (size_t)m * DM : p.xc + (size_t)(m - NLAT) * DM;
}
DI float* xrow_out(const Params& p, int m) {
  return m < NLAT ? p.out + (size_t)m * DM : p.xc + (size_t)(m - NLAT) * DM;
}
DI void norm_tile(const Params& p, int layer, int which, int t) {
  const int tid_ = TID(); const int wv = tid_ >> 6, lane = tid_ & 63;
  const int m = t * 8 + wv * 2;
  const float* xa = which == 0 ? xrow_ptr(p, layer, m) : xrow_out(p, m);
  const float* xb = xa + DM;
  const float* g = (which == 0 ? p.norm1_g : p.norm2_g) + layer * DM;
  const float* shift = p.mod + (size_t)(layer * 5 + modrow(m)) * 6144 + (which ? 3 * DM : 0);
  const float* scale = shift + DM;
  float4 va[4], vb[4], g4[4], sh[4], sc[4];
#pragma unroll
  for (int j = 0; j < 4; ++j) { va[j] = ((const float4*)xa)[lane + 64 * j]; vb[j] = ((const float4*)xb)[lane + 64 * j]; }
#pragma unroll
  for (int j = 0; j < 4; ++j) { g4[j] = ((const float4*)g)[lane + 64 * j]; sh[j] = ((const float4*)shift)[lane + 64 * j]; sc[j] = ((const float4*)scale)[lane + 64 * j]; }
  if (which == 0 && layer == 0) {
    float* ca = xrow_out(p, m);
#pragma unroll
    for (int j = 0; j < 4; ++j) { ((float4*)ca)[lane + 64 * j] = va[j]; ((float4*)(ca + DM))[lane + 64 * j] = vb[j]; }
  }
  float ssa = 0.f, ssb = 0.f;
#pragma unroll
  for (int j = 0; j < 4; ++j) {
    ssa += va[j].x * va[j].x + va[j].y * va[j].y + va[j].z * va[j].z + va[j].w * va[j].w;
    ssb += vb[j].x * vb[j].x + vb[j].y * vb[j].y + vb[j].z * vb[j].z + vb[j].w * vb[j].w;
  }
  ssa = wave_sum(ssa);
  ssb = wave_sum(ssb);
  const float ra = rsqrtf(ssa * (1.f / 1024.f) + 1e-6f), rb = rsqrtf(ssb * (1.f / 1024.f) + 1e-6f);
  u16* oa = p.hm + (size_t)m * DM;
#pragma unroll
  for (int j = 0; j < 4; ++j) {
    const int i4 = lane + 64 * j;
    uint2 o;
    o.x = pack2((va[j].x * ra * g4[j].x) * (1.f + sc[j].x) + sh[j].x, (va[j].y * ra * g4[j].y) * (1.f + sc[j].y) + sh[j].y);
    o.y = pack2((va[j].z * ra * g4[j].z) * (1.f + sc[j].z) + sh[j].z, (va[j].w * ra * g4[j].w) * (1.f + sc[j].w) + sh[j].w);
    ((uint2*)oa)[i4] = o;
    o.x = pack2((vb[j].x * rb * g4[j].x) * (1.f + sc[j].x) + sh[j].x, (vb[j].y * rb * g4[j].y) * (1.f + sc[j].y) + sh[j].y);
    o.y = pack2((vb[j].z * rb * g4[j].z) * (1.f + sc[j].z) + sh[j].z, (vb[j].w * rb * g4[j].w) * (1.f + sc[j].w) + sh[j].w);
    ((uint2*)(oa + DM))[i4] = o;
  }
}

template <int EPI>
DI void gemm_tile(const Params& p, int layer, const u16* __restrict__ A0, int a_rs, int a_ks, const u16* __restrict__ Bt, int K, int KT, int mt, int nt, char* smem) {
  const int tid = TID(), wv = tid >> 6, lane = tid & 63, l31 = lane & 31, h = lane >> 5;
  const int wm = wv >> 1, wn = wv & 1;
  const int m0 = mt * 128, n0 = nt * 128;
  f32x16 acc[2][2];
#pragma unroll
  for (int i = 0; i < 2; ++i)
#pragma unroll
    for (int j = 0; j < 2; ++j)
#pragma unroll
      for (int r = 0; r < 16; ++r) acc[i][j][r] = 0.f;
  const int lrow = tid >> 3, lch = tid & 7;
  const u16* ag = A0 + (size_t)lrow * a_rs + lch * 8;
  const u16* bg = Bt + (size_t)(n0 + lrow) * K + lch * 8;
  u32x4 ra0[4], rb0[4], ra1[4], rb1[4];
  char* As = smem;
  char* Bs = smem + 32768;
  auto g_load = [&](u32x4 (&RA)[4], u32x4 (&RB)[4], int kti) __attribute__((always_inline)) {
#pragma unroll
    for (int j = 0; j < 4; ++j) {
      RA[j] = *(const u32x4*)(ag + (size_t)(32 * j) * a_rs + (size_t)kti * a_ks);
      RB[j] = *(const u32x4*)(bg + (size_t)(32 * j) * K + kti * 64);
    }
  };
  auto g_store = [&](const u32x4 (&RA)[4], const u32x4 (&RB)[4], int buf) __attribute__((always_inline)) {
#pragma unroll
    for (int j = 0; j < 4; ++j) {
      int row = lrow + 32 * j;
      int off = buf * 16384 + row * 128 + ((lch ^ ((row >> 1) & 7)) << 4);
      *(u32x4*)(As + off) = RA[j];
      *(u32x4*)(Bs + off) = RB[j];
    }
  };
  auto g_frag = [&](bf16x8 (&fa)[2], bf16x8 (&fb)[2], const char* as, const char* bs, int kk) __attribute__((always_inline)) {
    const int chunk = kk * 2 + h;
#pragma unroll
    for (int i = 0; i < 2; ++i) {
      int row = wm * 64 + i * 32 + l31;
      fa[i] = *(const bf16x8*)(as + row * 128 + ((chunk ^ ((row >> 1) & 7)) << 4));
      int rowb = wn * 64 + i * 32 + l31;
      fb[i] = *(const bf16x8*)(bs + rowb * 128 + ((chunk ^ ((rowb >> 1) & 7)) << 4));
    }
  };
  auto g_mma = [&](const bf16x8 (&fa)[2], const bf16x8 (&fb)[2]) __attribute__((always_inline)) {
#pragma unroll
    for (int i = 0; i < 2; ++i)
#pragma unroll
      for (int j = 0; j < 2; ++j) acc[i][j] = __builtin_amdgcn_mfma_f32_32x32x16_bf16(fa[i], fb[j], acc[i][j], 0, 0, 0);
  };
  auto g_compute = [&](int buf) __attribute__((always_inline)) {
    const char* as = As + buf * 16384;
    const char* bs = Bs + buf * 16384;
    bf16x8 fa0[2], fb0[2], fa1[2], fb1[2];
    g_frag(fa0, fb0, as, bs, 0);
    g_frag(fa1, fb1, as, bs, 1);
    __builtin_amdgcn_sched_barrier(0);
    g_mma(fa0, fb0);
    __builtin_amdgcn_sched_barrier(0);
    g_frag(fa0, fb0, as, bs, 2);
    __builtin_amdgcn_sched_barrier(0);
    g_mma(fa1, fb1);
    __builtin_amdgcn_sched_barrier(0);
    g_frag(fa1, fb1, as, bs, 3);
    __builtin_amdgcn_sched_barrier(0);
    g_mma(fa0, fb0);
    g_mma(fa1, fb1);
  };
  g_load(ra0, rb0, 0);
  g_load(ra1, rb1, 1);
  g_store(ra0, rb0, 0);
  __syncthreads();
  g_load(ra0, rb0, 2);
  for (int kt = 0; kt < KT; kt += 2) {
    g_compute(0);
    g_store(ra1, rb1, 1);
    __syncthreads();
    if (kt + 3 < KT) g_load(ra1, rb1, kt + 3);
    g_compute(1);
    if (kt + 2 < KT) g_store(ra0, rb0, 0);
    __syncthreads();
    if (kt + 4 < KT) g_load(ra0, rb0, kt + 4);
  }
  if (EPI == 1 || EPI == 3 || EPI == 5) {
    const float* gbase = p.mod + (size_t)(layer * 5 + modrow(m0)) * 6144 + ((EPI == 1) ? 2 : 5) * DM;
    float* xb = xrow_out(p, m0 + wm * 64 + 4 * h);
#pragma unroll
    for (int j = 0; j < 2; ++j) {
      const int col = n0 + wn * 64 + j * 32 + l31;
      const float gate = gbase[col] * ((EPI == 5) ? 0.0f : 1.0f);
      float xv[2][16];
#pragma unroll
      for (int i = 0; i < 2; ++i)
#pragma unroll
        for (int r = 0; r < 16; ++r) xv[i][r] = xb[(size_t)(i * 32 + (r & 3) + 8 * (r >> 2)) * DM + col];
#pragma unroll
      for (int i = 0; i < 2; ++i)
#pragma unroll
        for (int r = 0; r < 16; ++r) xb[(size_t)(i * 32 + (r & 3) + 8 * (r >> 2)) * DM + col] = xv[i][r] + gate * acc[i][j][r];
    }
    return;
  }
#pragma unroll
  for (int i = 0; i < 2; ++i) {
#pragma unroll
    for (int j = 0; j < 2; ++j) {
      const int col = n0 + wn * 64 + j * 32 + l31;
#pragma unroll
      for (int r = 0; r < 16; ++r) {
        const int row = m0 + wm * 64 + i * 32 + (r & 3) + 8 * (r >> 2) + 4 * h;
        const float v = acc[i][j][r];
        if (EPI == 0) {
          if (col < PAW) p.pa[(size_t)row * PAW + col] = v;
          else if (col < DIN) p.pb[(size_t)row * PBW + (col - PAW)] = (u16)(pack2(v, 0.f) & 0xffff);
        } else if (EPI == 4) {
          float* xo = xrow_out(p, row);
          const float gate = p.mod[(size_t)(layer * 5 + modrow(row)) * 6144 + 5 * DM + col];
          atomicAdd(xo + col, gate * v);
        } else {
          float rl = fmaxf(v, 0.f);
          p.u[((size_t)((row >> 7) * 64 + (col >> 6)) * 128 + (row & 127)) * 64 + (col & 63)] = (u16)(pack2(rl * rl, 0.f) & 0xffff);
        }
      }
    }
  }
}

DI float fsigmoid(float x) { return __builtin_amdgcn_rcpf(1.f + __builtin_amdgcn_exp2f(-x * LOG2E)); }
constexpr int PTOK = 34;
DI void rwkv_prep_tile(const Params& p, int layer, int t, char* smem) {
  const int tid = TID(), lane = tid & 63, wv = tid >> 6;
  const int m0 = t * PTOK, j = tid;
  float* lo = (float*)smem;
  for (int i = tid; i < PTOK * 128; i += 256) {
    int tok = i >> 7, cc = i & 127;
    float v = p.pa[(size_t)(m0 + tok) * PAW + 768 + cc];
    if (cc < 64) v = 2.f * fsigmoid(2.f * v) - 1.f;
    lo[i] = v;
  }
  const float kkc = p.rw_kk[layer * 256 + j], kac = p.rw_ka[layer * 256 + j], rkc = p.rw_rk[layer * 256 + j];
  __syncthreads();
  {
    float wf[32], wb[32];
    const float* wq = launder(p.rw_w2 + (size_t)(layer * 2 * 32) * 256 + j);
#pragma unroll
    for (int k = 0; k < 32; ++k) {
      wf[k] = wq[k * 256];
      wb[k] = wq[(32 + k) * 256];
    }
    const float w0f = p.rw_w0[(layer * 2 + 0) * 256 + j], w0b = p.rw_w0[(layer * 2 + 1) * 256 + j];
#pragma unroll 1
    for (int tok = 0; tok < PTOK; ++tok) {
      float d0 = w0f, d1 = w0b;
      const float4* l4 = (const float4*)(lo + tok * 128);
#pragma unroll
      for (int k4 = 0; k4 < 8; ++k4) {
        float4 x0 = l4[k4], x1 = l4[8 + k4];
        d0 += x0.x * wf[4 * k4] + x0.y * wf[4 * k4 + 1] + x0.z * wf[4 * k4 + 2] + x0.w * wf[4 * k4 + 3];
        d1 += x1.x * wb[4 * k4] + x1.y * wb[4 * k4 + 1] + x1.z * wb[4 * k4 + 2] + x1.w * wb[4 * k4 + 3];
      }
      const size_t m = (size_t)(m0 + tok);
      p.decf[m * 256 + j] = __builtin_amdgcn_exp2f(-0.60653066f * LOG2E * fsigmoid(d0));
      p.decb[m * 256 + j] = __builtin_amdgcn_exp2f(-0.60653066f * LOG2E * fsigmoid(d1));
    }
  }
  {
    float a_f[32], a_b[32];
    const float* aq = launder(p.rw_a2 + (size_t)(layer * 2 * 32) * 256 + j);
#pragma unroll
    for (int k = 0; k < 32; ++k) {
      a_f[k] = aq[k * 256];
      a_b[k] = aq[(32 + k) * 256];
    }
    const float a0f = p.rw_a0[(layer * 2 + 0) * 256 + j], a0b = p.rw_a0[(layer * 2 + 1) * 256 + j];
#pragma unroll 1
    for (int tok = 0; tok < PTOK; ++tok) {
      float d2 = a0f, d3 = a0b;
      const float4* l4 = (const float4*)(lo + tok * 128);
#pragma unroll
      for (int k4 = 0; k4 < 8; ++k4) {
        float4 x2 = l4[16 + k4], x3 = l4[24 + k4];
        d2 += x2.x * a_f[4 * k4] + x2.y * a_f[4 * k4 + 1] + x2.z * a_f[4 * k4 + 2] + x2.w * a_f[4 * k4 + 3];
        d3 += x3.x * a_b[4 * k4] + x3.y * a_b[4 * k4 + 1] + x3.z * a_b[4 * k4 + 2] + x3.w * a_b[4 * k4 + 3];
      }
      const float af = fsigmoid(d2);
      const float ab = fsigmoid(d3);
      const size_t m = (size_t)(m0 + tok);
      const float r = p.pa[m * PAW + j], k = p.pa[m * PAW + 256 + j];
      const float kr = k * kkc;
      const float ss = wave_sum(kr * kr);
      const float kkn = kr * rsqrtf(fmaxf(ss, 1e-24f));
      const float kmf = k * (1.f + (af - 1.f) * kac), kmb = k * (1.f + (ab - 1.f) * kac);
      const float bs = wave_sum(r * (kmf + kmb) * rkc);
      p.af[m * 256 + j] = af; p.ab[m * 256 + j] = ab; p.kk[m * 256 + j] = kkn;
      if (lane == 0) p.bon[m * 4 + wv] = bs;
    }
  }
  __syncthreads();
}

DI void attn_prep_tile(const Params& p, int layer, int t, char* smem) {
  const int tid = TID();
  const int m0 = t * 64;
  int b, pos0, islat, grow;
  if (m0 < NLAT) { b = m0 >> 12; int tl = m0 & 4095; pos0 = CTXL + tl; islat = 1; grow = tl >> 6; }
  else { b = (m0 - NLAT) >> 8; pos0 = (m0 - NLAT) & 255; islat = 0; grow = 0; }
  const int tok = tid >> 2, c = tid & 3;
  const size_t m = (size_t)(m0 + tok);
  u16* T = (u16*)smem;
#pragma unroll 1
  for (int s = 0; s < 20; ++s) {
    const u16* src = p.pb + m * PBW + s * 64 + c * 16;
    uint4 r0 = *(const uint4*)src, r1 = *(const uint4*)(src + 8);
    float x[16];
    x[0] = bflo(r0.x); x[1] = bfhi(r0.x); x[2] = bflo(r0.y); x[3] = bfhi(r0.y);
    x[4] = bflo(r0.z); x[5] = bfhi(r0.z); x[6] = bflo(r0.w); x[7] = bfhi(r0.w);
    x[8] = bflo(r1.x); x[9] = bfhi(r1.x); x[10] = bflo(r1.y); x[11] = bfhi(r1.y);
    x[12] = bflo(r1.z); x[13] = bfhi(r1.z); x[14] = bflo(r1.w); x[15] = bfhi(r1.w);
    const bool isv = (s >= 8 && s < 12) || s >= 18;
    if (!isv) {
      u16* dst;
      float scl = 1.f;
      if (s < 4) { dst = p.qb + ((size_t)(b * 4 + s) * SALL + pos0 + tok) * 64; scl = QSCALE; }
      else if (s < 8) { dst = p.kb + ((size_t)(b * 4 + (s - 4)) * SALL + pos0 + tok) * 64; }
      else if (s < 16) { dst = p.qc + ((size_t)(b * 4 + (s - 12)) * SALL + pos0 + tok) * 64; scl = QSCALE; }
      else { dst = p.kc + ((size_t)(b * 2 + (s - 16)) * SALL + pos0 + tok) * 64; }
      if (s >= 12) {
        float ss = 0.f;
#pragma unroll
        for (int i = 0; i < 16; ++i) ss += x[i] * x[i];
        ss = dpp_add<0xB1>(ss);
        ss = dpp_add<0x4E>(ss);
        const float rstd = rsqrtf(ss * (1.f / 64.f) + 1e-6f);
        const float* gn = (s < 16 ? p.q_gain : p.k_gain) + layer * 64 + c * 16;
#pragma unroll
        for (int i = 0; i < 16; ++i) x[i] = x[i] * rstd * gn[i];
        if (islat) {
          const int posv = (c & 1) ? tok : grow;
          const float sgn = (c < 2) ? -1.f : 1.f;
          const float* rt = p.rope + (size_t)posv * 32;
#pragma unroll
          for (int i = 0; i < 16; ++i) {
            float part = __builtin_bit_cast(float, __builtin_amdgcn_update_dpp(0, __builtin_bit_cast(int, x[i]), 0x4E, 0xf, 0xf, true));
            float cs = rt[2 * i], sn = rt[2 * i + 1];
            x[i] = x[i] * cs + sgn * part * sn;
          }
        }
      }
      uint4 o0, o1;
      o0.x = pack2(x[0] * scl, x[1] * scl); o0.y = pack2(x[2] * scl, x[3] * scl);
      o0.z = pack2(x[4] * scl, x[5] * scl); o0.w = pack2(x[6] * scl, x[7] * scl);
      o1.x = pack2(x[8] * scl, x[9] * scl); o1.y = pack2(x[10] * scl, x[11] * scl);
      o1.z = pack2(x[12] * scl, x[13] * scl); o1.w = pack2(x[14] * scl, x[15] * scl);
      *(uint4*)(dst + c * 16) = o0;
      *(uint4*)(dst + c * 16 + 8) = o1;
    } else {
      const unsigned wd[8] = {r0.x, r0.y, r0.z, r0.w, r1.x, r1.y, r1.z, r1.w};
#pragma unroll
      for (int i = 0; i < 8; ++i) {
        T[(c * 16 + 2 * i) * 72 + tok] = (u16)(wd[i] & 0xffffu);
        T[(c * 16 + 2 * i + 1) * 72 + tok] = (u16)(wd[i] >> 16);
      }
      __syncthreads();
      const int d = tid >> 2, ch = tid & 3;
      uint4 v0 = *(const uint4*)(T + d * 72 + ch * 16), v1 = *(const uint4*)(T + d * 72 + ch * 16 + 8);
      u16* dst = (s < 12) ? p.vtb + ((size_t)(b * 4 + (s - 8)) * 64 + d) * SALL + pos0 + ch * 16
                          : p.vtc + ((size_t)(b * 2 + (s - 18)) * 64 + d) * SALL + pos0 + ch * 16;
      *(uint4*)dst = v0;
      *(uint4*)(dst + 8) = v1;
      __syncthreads();
    }
  }
}

DI void pool_tile(const Params& p, int layer, int t, char* smem) {
  const int tid = TID(), lane = tid & 63, g = tid >> 6;
  const int m0 = t * 64;
  int tl, n, mbase;
  if (m0 < NLAT) { tl = m0 & 4095; n = SEQ; mbase = m0 - tl; }
  else { tl = (m0 - NLAT) & 255; n = CTXL; mbase = m0 - tl; }
  u16* sp = (u16*)smem;
  float* sdiff = (float*)(smem + 40960);
  for (int i = tid; i < 80 * 32; i += 256) {
    int row = i >> 5, c8 = i & 31;
    int tt = tl - 8 + row;
    if (tt >= 0 && tt < n) *(uint4*)(sp + row * 256 + c8 * 8) = *(const uint4*)(p.pb + (size_t)(mbase + tt) * PBW + 1280 + c8 * 8);
  }
  float wreg[64];
  const float* wp0 = launder(p.pool_w + (size_t)((layer * 4 + g) * 64) * 64 + lane);
#pragma unroll
  for (int cc = 0; cc < 64; ++cc) wreg[cc] = wp0[cc * 64];
  const float psc = p.pool_scale[layer * 256 + tid];
  const int w = 2 << g;
  __syncthreads();
#pragma unroll 1
  for (int sub = 0; sub < 4; ++sub) {
#pragma unroll 1
    for (int tt = 0; tt < 16; ++tt) {
      int tq = tl + sub * 16 + tt;
      int lo = max(tq - w / 2, 0), hi = min(tq - w / 2 + w, n);
      float sum = 0.f;
      for (int u = lo; u < hi; ++u) sum += bf2f(sp[(u - tl + 8) * 256 + tid]);
      float self = bf2f(sp[(tq - tl + 8) * 256 + tid]);
      sdiff[tt * 256 + tid] = sum / (float)(hi - lo) - self;
    }
    __syncthreads();
#pragma unroll 1
    for (int tt = 0; tt < 16; ++tt) {
      const float4* d4 = (const float4*)(sdiff + tt * 256 + g * 64);
      float acc = 0.f;
#pragma unroll
      for (int c4 = 0; c4 < 16; ++c4) {
        float4 dv = d4[c4];
        acc += dv.x * wreg[4 * c4] + dv.y * wreg[4 * c4 + 1] + dv.z * wreg[4 * c4 + 2] + dv.w * wreg[4 * c4 + 3];
      }
      p.hm[(size_t)(m0 + sub * 16 + tt) * DM + 768 + tid] = (u16)(pack2(acc * psc, 0.f) & 0xffff);
    }
    __syncthreads();
  }
}

template <int LPRv> DI float row_reduce(float x) {
  x = dpp_add<0xB1>(x);
  x = dpp_add<0x4E>(x);
  if (LPRv >= 8) x = dpp_add<0x141>(x);
  if (LPRv >= 16) x = dpp_add<0x140>(x);
  return x;
}
DI int scan_tok(int b, int dir, int c, int i) {
  if (c < 16) { int s = c * 16 + i; return NLAT + b * CTXL + (dir ? (CTXL - 1 - s) : s); }
  int s = (c - 16) * 16 + i;
  return b * SEQ + (dir ? (SEQ - 1 - s) : s);
}
typedef float v4f __attribute__((ext_vector_type(4)));
typedef float v2f __attribute__((ext_vector_type(2)));
#define SCAN_LD(nw, nk, nb, nm, nr, nv, aaddr, vaddr, SA, SB) asm volatile( \
    "ds_read_b128 %0, %8\n\tds_read_b128 %1, %8 offset:4096\n\tds_read_b128 %2, %8 offset:8192\n\tds_read_b128 %3, %8 offset:12288\n\tds_read_b128 %4, %8 offset:16384\n\tds_read_b32 %5, %9" \
    : "=&v"(nw), "=&v"(nk), "=&v"(nb), "=&v"(nm), "=&v"(nr), "=&v"(nv), "+v"(SA), "+v"(SB) : "v"(aaddr), "v"(vaddr))
#define SCAN_LDI(nw, nk, nb, nm, nr, nv, aaddr, vaddr, SA, SB, OFF) asm volatile( \
    "ds_read_b128 %0, %8 offset:%10\n\tds_read_b128 %1, %8 offset:%11\n\tds_read_b128 %2, %8 offset:%12\n\tds_read_b128 %3, %8 offset:%13\n\tds_read_b128 %4, %8 offset:%14\n\tds_read_b32 %5, %9 offset:%10" \
    : "=&v"(nw), "=&v"(nk), "=&v"(nb), "=&v"(nm), "=&v"(nr), "=&v"(nv), "+v"(SA), "+v"(SB) : "v"(aaddr), "v"(vaddr), \
      "n"(OFF), "n"((OFF) + 4096), "n"((OFF) + 8192), "n"((OFF) + 12288), "n"((OFF) + 16384))
#define SCAN_WAIT(nw, nk, nb, nm, nr, nv, SA, SB) asm volatile("s_waitcnt lgkmcnt(0)" : "+v"(nw), "+v"(nk), "+v"(nb), "+v"(nm), "+v"(nr), "+v"(nv), "+v"(SA), "+v"(SB))
#define SCAN_WAIT6(nw, nk, nb, nm, nr, nv, SA, SB) asm volatile("s_waitcnt lgkmcnt(6)" : "+v"(nw), "+v"(nk), "+v"(nb), "+v"(nm), "+v"(nr), "+v"(nv), "+v"(SA), "+v"(SB))
template <int CTRL> DI float dpp_mov(float x) {
  return __builtin_bit_cast(float, __builtin_amdgcn_update_dpp(0, __builtin_bit_cast(int, x), CTRL, 0xf, 0xf, true));
}
DI void scan_item(const Params& p, int layer, int sb, char* smem) {
  constexpr int LPR = 64 / KPL, RPB = 4 * KPL, BPI = 16 / KPL, YPL = 16 / LPR;
  const int tid = TID(), wv = tid >> 6, lane = tid & 63;
  const int item = sb / BPI, part = sb % BPI;
  const int b = item >> 3, hh = (item >> 1) & 3, dir = item & 1;
  const int row = part * RPB + wv * KPL + lane / LPR, kq = lane % LPR;
  const float* dec = dir ? p.decb : p.decf;
  const float* aa = dir ? p.ab : p.af;
  float* Y = dir ? p.yb : p.yf;
  const int li = tid >> 4, lf = tid & 15;
  const float4 ka4 = *(const float4*)(p.rw_ka + layer * 256 + hh * 64 + lf * 4);
  v2f SA = {0.f, 0.f}, SB = {0.f, 0.f};
  const bool c3 = (kq & 8) != 0, c2 = (kq & 4) != 0, c1 = (kq & 2) != 0, c0 = (kq & 1) != 0;
  const int sidx = (c3 ? 8 : 0) + (c2 ? 4 : 0) + (c0 ? 2 : 0) + (c1 ? 1 : 0);
  float* bufs = (float*)smem;
  const unsigned lds0 = (unsigned)(size_t)smem;
  float4 gr, gk, gv, gd, ga, gkk;
  auto gload = [&](int c) {
    size_t m = (size_t)scan_tok(b, dir, c, li);
    const float* pr = p.pa + m * PAW + hh * 64 + lf * 4;
    gr = *(const float4*)pr; gk = *(const float4*)(pr + 256); gv = *(const float4*)(pr + 512);
    size_t o = m * 256 + hh * 64 + lf * 4;
    gd = *(const float4*)(dec + o); ga = *(const float4*)(aa + o); gkk = *(const float4*)(p.kk + o);
  };
  auto lstore = [&](int bi) {
    float* bb = bufs + bi * 6144 + li * 64 + lf * 4;
    *(float4*)(bb) = gd;
    *(float4*)(bb + 1024) = gkk;
    *(float4*)(bb + 2048) = make_float4(gkk.x * ga.x, gkk.y * ga.y, gkk.z * ga.z, gkk.w * ga.w);
    *(float4*)(bb + 3072) = make_float4(gk.x * (1.f + (ga.x - 1.f) * ka4.x), gk.y * (1.f + (ga.y - 1.f) * ka4.y),
                                        gk.z * (1.f + (ga.z - 1.f) * ka4.z), gk.w * (1.f + (ga.w - 1.f) * ka4.w));
    *(float4*)(bb + 4096) = gr;
    *(float4*)(bb + 5120) = gv;
  };
  __builtin_amdgcn_s_setprio(3);
  gload(0);
  lstore(0);
  __syncthreads();
  for (int c = 0; c < 272; ++c) {
    if (c + 1 < 272) gload(c + 1);
    float yp[16];
    v4f qw[3], qk[3], qb[3], qm[3], qr[3];
    float qv[3];
    const unsigned abase = lds0 + (unsigned)(c & 1) * 24576u + (unsigned)kq * 16u;
    const unsigned vbase = lds0 + (unsigned)(c & 1) * 24576u + 20480u + (unsigned)row * 4u;
    SCAN_LDI(qw[0], qk[0], qb[0], qm[0], qr[0], qv[0], abase, vbase, SA, SB, 0);
    SCAN_LDI(qw[1], qk[1], qb[1], qm[1], qr[1], qv[1], abase, vbase, SA, SB, 256);
    SCAN_WAIT6(qw[0], qk[0], qb[0], qm[0], qr[0], qv[0], SA, SB);
#define SCAN_STEP(I) { \
      constexpr int cs = (I) % 3, ns = ((I) + 1) % 3, fs = ((I) + 2) % 3; \
      const v2f w0 = {qw[cs][0], qw[cs][1]}, w1 = {qw[cs][2], qw[cs][3]}, k0 = {qk[cs][0], qk[cs][1]}, k1 = {qk[cs][2], qk[cs][3]}; \
      const v2f b0 = {qb[cs][0], qb[cs][1]}, b1 = {qb[cs][2], qb[cs][3]}, m0 = {qm[cs][0], qm[cs][1]}, m1 = {qm[cs][2], qm[cs][3]}; \
      const v2f r0 = {qr[cs][0], qr[cs][1]}, r1 = {qr[cs][2], qr[cs][3]}; \
      const float vv = qv[cs]; \
      if ((I) + 2 < 16) { SCAN_LDI(qw[fs], qk[fs], qb[fs], qm[fs], qr[fs], qv[fs], abase, vbase, SA, SB, (((I) + 2) & 15) * 256); } \
      v2f t = SA * k0; \
      t = __builtin_elementwise_fma(SB, k1, t); \
      const float sa = row_reduce<LPR>(t[0] + t[1]); \
      const v2f nsa = {-sa, -sa}, vv2 = {vv, vv}; \
      SA = __builtin_elementwise_fma(vv2, m0, __builtin_elementwise_fma(nsa, b0, SA * w0)); \
      SB = __builtin_elementwise_fma(vv2, m1, __builtin_elementwise_fma(nsa, b1, SB * w1)); \
      v2f u = SA * r0; \
      u = __builtin_elementwise_fma(SB, r1, u); \
      yp[I] = u[0] + u[1]; \
      if ((I) + 1 < 16) { \
        if ((I) + 2 < 16) { SCAN_WAIT6(qw[ns], qk[ns], qb[ns], qm[ns], qr[ns], qv[ns], SA, SB); } \
        else { SCAN_WAIT(qw[ns], qk[ns], qb[ns], qm[ns], qr[ns], qv[ns], SA, SB); } \
      } }
    SCAN_STEP(0) SCAN_STEP(1) SCAN_STEP(2) SCAN_STEP(3) SCAN_STEP(4) SCAN_STEP(5) SCAN_STEP(6) SCAN_STEP(7)
    SCAN_STEP(8) SCAN_STEP(9) SCAN_STEP(10) SCAN_STEP(11) SCAN_STEP(12) SCAN_STEP(13) SCAN_STEP(14) SCAN_STEP(15)
#undef SCAN_STEP
    float yfin;
    {
      float q[8], r4[4], r2[2];
#pragma unroll
      for (int m = 0; m < 8; ++m) { float mine = c3 ? yp[m + 8] : yp[m]; float oth = c3 ? yp[m] : yp[m + 8]; q[m] = mine + dpp_mov<0x128>(oth); }
#pragma unroll
      for (int m = 0; m < 4; ++m) { float mine = c2 ? q[m + 4] : q[m]; float oth = c2 ? q[m] : q[m + 4]; r4[m] = mine + dpp_mov<0x141>(oth); }
#pragma unroll
      for (int m = 0; m < 2; ++m) { float mine = c0 ? r4[m + 2] : r4[m]; float oth = c0 ? r4[m] : r4[m + 2]; r2[m] = mine + dpp_mov<0xB1>(oth); }
      float mine = c1 ? r2[1] : r2[0]; float oth = c1 ? r2[0] : r2[1];
      yfin = mine + dpp_mov<0x4E>(oth);
    }
    {
      size_t m = (size_t)scan_tok(b, dir, c, sidx);
      Y[m * 256 + hh * 64 + row] = yfin;
    }
    if (c + 1 < 272) lstore((c + 1) & 1);
    __syncthreads();
  }
  __builtin_amdgcn_s_setprio(0);
}

template <int NA>
DI void attn_item(const Params& p, const u16* __restrict__ Qb, const u16* __restrict__ Kb, const u16* __restrict__ Vtb, int ntiles,
                  int mrow0, int colbase, int rp, const float* rpbh, char* smem) {
  const int tid = TID(), wv = tid >> 6, lane = tid & 63, l31 = lane & 31, h = lane >> 5;
  char* Kbuf = smem;
  char* Vbuf = smem + 16384;
  float* rpbL = (float*)(smem + 16384 + 17408);
  int rs0 = 0, nloc = 0, qr = 0, myrs = 0;
  if (NA) {
    int r0 = rp * 2, r1 = r0 + 1;
    rs0 = min(max(r0 - 4, 0), 56);
    int rs1 = min(max(r1 - 4, 0), 56);
    nloc = rs1 + 8 - rs0;
    qr = r0 + (wv >> 1);
    myrs = min(max(qr - 4, 0), 56);
    for (int i = tid; i < 465; i += 256) rpbL[i] = rpbh[i] * LOG2E;
  }
  bf16x8 qf[4];
  {
    const u16* qp = Qb + (size_t)(wv * 32 + l31) * 64 + 8 * h;
#pragma unroll
    for (int kk = 0; kk < 4; ++kk) qf[kk] = *(const bf16x8*)(qp + kk * 16);
  }
  f32x16 o[2];
#pragma unroll
  for (int dt = 0; dt < 2; ++dt)
#pragma unroll
    for (int r = 0; r < 16; ++r) o[dt][r] = 0.f;
  float mrun = -INFINITY, lsum = 0.f;
  const int lr = tid >> 2, lc = tid & 3;
  struct TileRegs { u32x4 k0, k1, v0, v1; };
  TileRegs ta, tb;
  auto tilepos = [&](int j) -> int {
    if (NA) return j < nloc ? CTXL + (rs0 + j) * 64 : (j - nloc) * 64;
    return j * 64;
  };
  auto gload = [&](TileRegs& tr, int j) __attribute__((always_inline)) {
    int pos0 = tilepos(j);
    const u16* ks = Kb + (size_t)(pos0 + lr) * 64 + lc * 16;
    tr.k0 = *(const u32x4*)ks; tr.k1 = *(const u32x4*)(ks + 8);
    const u16* vs = Vtb + (size_t)lr * SALL + pos0 + lc * 16;
    tr.v0 = *(const u32x4*)vs; tr.v1 = *(const u32x4*)(vs + 8);
  };
  auto lstore = [&](const TileRegs& tr, int bi) __attribute__((always_inline)) {
    char* kb = Kbuf + bi * 8192 + lr * 128;
    int sw = (lr >> 1) & 7;
    *(u32x4*)(kb + (((lc * 2) ^ sw) << 4)) = tr.k0;
    *(u32x4*)(kb + (((lc * 2 + 1) ^ sw) << 4)) = tr.k1;
    char* vb = Vbuf + bi * 8704 + lr * 136 + lc * 32;
    *(uint2*)(vb) = make_uint2(tr.v0[0], tr.v0[1]);
    *(uint2*)(vb + 8) = make_uint2(tr.v0[2], tr.v0[3]);
    *(uint2*)(vb + 16) = make_uint2(tr.v1[0], tr.v1[1]);
    *(uint2*)(vb + 24) = make_uint2(tr.v1[2], tr.v1[3]);
  };
  auto compute = [&](int j, int bi) __attribute__((always_inline)) {
    bool skip = false;
    int krow = 0;
    bool local = false;
    if (NA && j < nloc) { local = true; krow = rs0 + j; skip = (krow < myrs) || (krow >= myrs + 8); }
    if (!skip) {
      const char* kb = Kbuf + bi * 8192;
      const char* vb = Vbuf + bi * 8704;
      f32x16 s[2];
#pragma unroll
      for (int sub = 0; sub < 2; ++sub) {
#pragma unroll
        for (int r = 0; r < 16; ++r) s[sub][r] = 0.f;
        const int row = sub * 32 + l31;
#pragma unroll
        for (int kk = 0; kk < 4; ++kk) {
          bf16x8 a = *(const bf16x8*)(kb + row * 128 + (((kk * 2 + h) ^ ((row >> 1) & 7)) << 4));
          s[sub] = __builtin_amdgcn_mfma_f32_32x32x16_bf16(a, qf[kk], s[sub], 0, 0, 0);
        }
      }
      if (NA && local) {
        const int qc = (wv & 1) * 32 + l31;
        const int cs = min(max(qc - 8, 0), 48);
        const float* brow = rpbL + (krow - qr + 7) * 31 + 15 - qc;
#pragma unroll
        for (int sub = 0; sub < 2; ++sub)
#pragma unroll
          for (int r = 0; r < 16; ++r) {
            int kc = sub * 32 + (r & 3) + 8 * (r >> 2) + 4 * h;
            bool valid = (kc >= cs) && (kc < cs + 16);
            float bias = valid ? brow[kc] : 0.f;
            s[sub][r] = valid ? s[sub][r] + bias : -INFINITY;
          }
      }
      float mx = s[0][0];
#pragma unroll
      for (int r = 1; r < 16; ++r) mx = fmaxf(mx, s[0][r]);
#pragma unroll
      for (int r = 0; r < 16; ++r) mx = fmaxf(mx, s[1][r]);
      mx = fmaxf(mx, __shfl_xor(mx, 32));
      const float mnew = fmaxf(mrun, mx);
      const float alpha = __builtin_amdgcn_exp2f(mrun - mnew);
      mrun = mnew;
      float ps = 0.f;
#pragma unroll
      for (int sub = 0; sub < 2; ++sub)
#pragma unroll
        for (int r = 0; r < 16; ++r) { float e = __builtin_amdgcn_exp2f(s[sub][r] - mnew); s[sub][r] = e; ps += e; }
      lsum = lsum * alpha + ps;
#pragma unroll
      for (int dt = 0; dt < 2; ++dt)
#pragma unroll
        for (int r = 0; r < 16; ++r) o[dt][r] *= alpha;
#pragma unroll
      for (int sub = 0; sub < 2; ++sub) {
#pragma unroll
        for (int s16 = 0; s16 < 2; ++s16) {
          unsigned pk[4];
#pragma unroll
          for (int e = 0; e < 4; ++e) pk[e] = pack2(s[sub][8 * s16 + 2 * e], s[sub][8 * s16 + 2 * e + 1]);
          bf16x8 pb = __builtin_bit_cast(bf16x8, *(uint4*)pk);
#pragma unroll
          for (int dt = 0; dt < 2; ++dt) {
            const char* va = vb + (32 * dt + l31) * 136 + (32 * sub + 16 * s16 + 4 * h) * 2;
            uint2 v0 = *(const uint2*)va, v1 = *(const uint2*)(va + 16);
            uint4 vv = make_uint4(v0.x, v0.y, v1.x, v1.y);
            bf16x8 a = __builtin_bit_cast(bf16x8, vv);
            o[dt] = __builtin_amdgcn_mfma_f32_32x32x16_bf16(a, pb, o[dt], 0, 0, 0);
          }
        }
      }
    }
  };
  gload(ta, 0);
  if (ntiles > 1) gload(tb, 1);
  lstore(ta, 0);
  __syncthreads();
  if (ntiles > 2) gload(ta, 2);
#pragma unroll 1
  for (int j = 0; j < ntiles; j += 2) {
    compute(j, 0);
    if (j + 1 < ntiles) lstore(tb, 1);
    __syncthreads();
    if (j + 3 < ntiles) gload(tb, j + 3);
    if (j + 1 < ntiles) compute(j + 1, 1);
    if (j + 2 < ntiles) lstore(ta, 0);
    __syncthreads();
    if (j + 4 < ntiles) gload(ta, j + 4);
  }
  const float ltot = lsum + __shfl_xor(lsum, 32);
  const float inv = 1.f / ltot;
  u16* orow = p.hm + (size_t)(mrow0 + wv * 32 + l31) * DM + colbase;
#pragma unroll
  for (int dt = 0; dt < 2; ++dt)
#pragma unroll
    for (int i4 = 0; i4 < 4; ++i4) {
      int d0 = 32 * dt + 8 * i4 + 4 * h;
      uint2 ov;
      ov.x = pack2(o[dt][4 * i4] * inv, o[dt][4 * i4 + 1] * inv);
      ov.y = pack2(o[dt][4 * i4 + 2] * inv, o[dt][4 * i4 + 3] * inv);
      *(uint2*)(orow + d0) = ov;
    }
}

DI void attn_dispatch(const Params& p, int layer, int it, char* smem) {
  if (it < 512) {
    int b = it >> 7, hd = (it >> 5) & 3, qt = it & 31;
    const u16* Q = p.qc + ((size_t)(b * 4 + hd) * SALL + CTXL + qt * 128) * 64;
    const u16* K = p.kc + (size_t)(b * 2 + (hd >> 1)) * SALL * 64;
    const u16* V = p.vtc + (size_t)(b * 2 + (hd >> 1)) * 64 * SALL;
    attn_item<0>(p, Q, K, V, 68, b * SEQ + qt * 128, 512 + hd * 64, 0, nullptr, smem);
  } else if (it < 1024) {
    int i2 = it - 512;
    int b = i2 >> 7, hd = (i2 >> 5) & 3, rp = i2 & 31;
    const u16* Q = p.qb + ((size_t)(b * 4 + hd) * SALL + CTXL + rp * 128) * 64;
    const u16* K = p.kb + (size_t)(b * 4 + hd) * SALL * 64;
    const u16* V = p.vtb + (size_t)(b * 4 + hd) * 64 * SALL;
    int r0 = rp * 2;
    int rs0 = min(max(r0 - 4, 0), 56), rs1 = min(max(r0 + 1 - 4, 0), 56);
    attn_item<1>(p, Q, K, V, (rs1 + 8 - rs0) + 4, b * SEQ + rp * 128, 256 + hd * 64, rp, p.na_rpb + (size_t)(layer * 4 + hd) * 465, smem);
  } else if (it < 1056) {
    int i2 = it - 1024;
    int b = i2 >> 3, hd = (i2 >> 1) & 3, hf = i2 & 1;
    const u16* Q = p.qc + ((size_t)(b * 4 + hd) * SALL + hf * 128) * 64;
    const u16* K = p.kc + (size_t)(b * 2 + (hd >> 1)) * SALL * 64;
    const u16* V = p.vtc + (size_t)(b * 2 + (hd >> 1)) * 64 * SALL;
    attn_item<0>(p, Q, K, V, 4, NLAT + b * CTXL + hf * 128, 512 + hd * 64, 0, nullptr, smem);
  } else {
    int i2 = it - 1056;
    int b = i2 >> 3, hd = (i2 >> 1) & 3, hf = i2 & 1;
    const u16* Q = p.qb + ((size_t)(b * 4 + hd) * SALL + hf * 128) * 64;
    const u16* K = p.kb + (size_t)(b * 4 + hd) * SALL * 64;
    const u16* V = p.vtb + (size_t)(b * 4 + hd) * 64 * SALL;
    attn_item<0>(p, Q, K, V, 4, NLAT + b * CTXL + hf * 128, 256 + hd * 64, 0, nullptr, smem);
  }
}
constexpr int N_ATT_ITEMS = 1088;

DI void readout_tile(const Params& p, int layer, int t, char* smem) {
  const int tid = TID(), wv = tid >> 6;
  const int m0 = t * PTOK;
  float* sg = (float*)smem;
  for (int i = tid; i < PTOK * 64; i += 256) {
    int tok = i >> 6, k = i & 63;
    float v = p.pa[(size_t)(m0 + tok) * PAW + 896 + k];
    sg[i] = fsigmoid(v);
  }
  float g2r[64];
  const float* gq = launder(p.rw_g2 + (size_t)(layer * 64) * 256 + tid);
#pragma unroll
  for (int k = 0; k < 64; ++k) g2r[k] = gq[k * 256];
  const float gnw = p.rw_gnw[layer * 256 + tid], gnb = p.rw_gnb[layer * 256 + tid];
  __syncthreads();
#pragma unroll 1
  for (int tok = 0; tok < PTOK; ++tok) {
    const size_t m = (size_t)(m0 + tok);
    const float y = p.yf[m * 256 + tid] + p.yb[m * 256 + tid];
    const float mu = wave_sum(y) * (1.f / 64.f);
    const float d = y - mu;
    const float var = wave_sum(d * d) * (1.f / 64.f);
    const float yn = d * rsqrtf(var + 6.4e-4f) * gnw + gnb;
    const float bonus = p.bon[m * 4 + wv] * p.pa[m * PAW + 512 + tid];
    const float4* s4 = (const float4*)(sg + tok * 64);
    float gate = 0.f;
#pragma unroll
    for (int k4 = 0; k4 < 16; ++k4) {
      float4 sv = s4[k4];
      gate += sv.x * g2r[4 * k4] + sv.y * g2r[4 * k4 + 1] + sv.z * g2r[4 * k4 + 2] + sv.w * g2r[4 * k4 + 3];
    }
    p.hm[m * DM + tid] = (u16)(pack2((yn + bonus) * gate, 0.f) & 0xffff);
  }
  __syncthreads();
}

DI void final_tile(const Params& p, int t) {
  const int tid_ = TID(); const int wv = tid_ >> 6, lane = tid_ & 63;
  float* xa = p.out + (size_t)(t * 8 + wv * 2) * DM;
  float* xb = xa + DM;
  float4 va[4], vb[4], g4[4];
#pragma unroll
  for (int j = 0; j < 4; ++j) { va[j] = ((const float4*)xa)[lane + 64 * j]; vb[j] = ((const float4*)xb)[lane + 64 * j]; g4[j] = ((const float4*)p.final_g)[lane + 64 * j]; }
  float ssa = 0.f, ssb = 0.f;
#pragma unroll
  for (int j = 0; j < 4; ++j) {
    ssa += va[j].x * va[j].x + va[j].y * va[j].y + va[j].z * va[j].z + va[j].w * va[j].w;
    ssb += vb[j].x * vb[j].x + vb[j].y * vb[j].y + vb[j].z * vb[j].z + vb[j].w * vb[j].w;
  }
  ssa = wave_sum(ssa);
  ssb = wave_sum(ssb);
  const float ra = rsqrtf(ssa * (1.f / 1024.f) + 1e-6f), rb = rsqrtf(ssb * (1.f / 1024.f) + 1e-6f);
#pragma unroll
  for (int j = 0; j < 4; ++j) {
    ((float4*)xa)[lane + 64 * j] = make_float4(va[j].x * ra * g4[j].x, va[j].y * ra * g4[j].y, va[j].z * ra * g4[j].z, va[j].w * ra * g4[j].w);
    ((float4*)xb)[lane + 64 * j] = make_float4(vb[j].x * rb * g4[j].x, vb[j].y * rb * g4[j].y, vb[j].z * rb * g4[j].z, vb[j].w * rb * g4[j].w);
  }
}

constexpr int NSCAN = 32 * (16 / KPL);
DI void convert_dispatch(const Params& p, int wl, int t, char* smem) {
  const size_t ws = (size_t)(wl & 1) * WSET;
  if (t < 640) convert_tile(p.w_in + (size_t)wl * DM * DIN, p.win + ws, DM, DIN, t / 40, t % 40, smem);
  else if (t < 896) { int u = t - 640; convert_tile(p.w_out + (size_t)wl * DM * DM, p.wout + ws, DM, DM, u / 16, u % 16, smem); }
  else if (t < 1920) { int u = t - 896; convert_tile(p.mlp_w1 + (size_t)wl * DM * DFF, p.w1 + ws, DM, DFF, u / 64, u % 64, smem); }
  else { int u = t - 1920; convert_tile(p.mlp_w2 + (size_t)wl * DFF * DM, p.w2 + ws, DFF, DM, u / 16, u % 16, smem); }
}
DI void sub_barrier(unsigned* ctr, unsigned expected) {
  asm volatile("s_waitcnt vmcnt(0)" ::: "memory");
  __syncthreads();
  if (threadIdx.x == 0) {
    __builtin_amdgcn_fence(__ATOMIC_RELEASE, "agent");
    asm volatile("s_waitcnt vmcnt(0)" ::: "memory");
    xb_add(ctr, 1u);
    unsigned sp = 0;
    while (xb_ld(ctr) < expected) { __builtin_amdgcn_s_sleep(1); if (++sp > (1u << 22)) break; }
    __builtin_amdgcn_fence(__ATOMIC_ACQUIRE, "agent");
    asm volatile("s_waitcnt vmcnt(0)" ::: "memory");
  }
  __syncthreads();
}
template <int PH>
DI void run_phase(const Params& p, int layer, char* smem, int role = -1, int ridx = 0) {
  const int bid = blockIdx.x, nb = gridDim.x;
  const size_t ws = (size_t)(layer & 1) * WSET;
  const bool last = (layer == DEPTH - 1);
  const int mtiles = last ? 128 : 136;
  if (PH == 0) {
    for (int t = bid; t < 385; t += nb) setup_tile(p, t, smem);
  } else if (PH == 1) {
    const int nconv = (layer == 0) ? 2944 : 0;
    for (int t = bid; t < nconv + 2176; t += nb) {
      if (t < nconv) convert_dispatch(p, layer, t, smem);
      else norm_tile(p, layer, 0, t - nconv);
    }
  } else if (PH == 2) {
    for (int t = bid; t < 136 * 20; t += nb) gemm_tile<0>(p, layer, p.hm + (size_t)(t / 20) * 128 * DM, DM, 64, p.win + ws, DM, 16, t / 20, t % 20, smem);
  } else if (PH == 3) {
    for (int t = bid; t < 512 + 272; t += nb) {
      if (t < 512) rwkv_prep_tile(p, layer, t, smem);
      else attn_prep_tile(p, layer, t - 512, smem);
    }
  } else if (PH == 4) {
    const bool is_scan = (role >= 0) ? (role == 0) : (bid < NSCAN);
    const bool is_partner = (role == 1);
    const int nconv = (layer + 1 < DEPTH) ? 2944 : 0;
    if (is_scan) {
      scan_item(p, layer, (role >= 0) ? ridx : bid, smem);
    } else if (is_partner) {
      for (int it = ridx; it < nconv; it += NSCAN) convert_dispatch(p, layer + 1, it, smem);
    } else {
      const int ab = (role >= 0) ? ridx : bid - NSCAN, nab = (role >= 0) ? 256 : nb - NSCAN;
      const int total = N_ATT_ITEMS + 272 + ((role >= 0) ? 0 : nconv);
      for (int it = ab; it < total; it += nab) {
        if (it < N_ATT_ITEMS) { if (!(last && it >= 1024)) attn_dispatch(p, layer, it, smem); }
        else if (it < N_ATT_ITEMS + 272) { if (!(last && it - N_ATT_ITEMS >= 256)) pool_tile(p, layer, it - N_ATT_ITEMS, smem); }
        else convert_dispatch(p, layer + 1, it - N_ATT_ITEMS - 272, smem);
      }
    }
  } else if (PH == 5) {
    for (int t = bid; t < (last ? 482 : 512); t += nb) readout_tile(p, layer, t, smem);
  } else if (PH == 6) {
    for (int t = bid; t < mtiles * 8; t += nb) gemm_tile<1>(p, layer, p.hm + (size_t)(t / 8) * 128 * DM, DM, 64, p.wout + ws, DM, 16, t / 8, t % 8, smem);
  } else if (PH == 7) {
    for (int t = bid; t < mtiles * 16; t += nb) norm_tile(p, layer, 1, t);
  } else if (PH == 8) {
    for (int t = bid; t < mtiles * 32; t += nb) gemm_tile<2>(p, layer, p.hm + (size_t)(t / 32) * 128 * DM, DM, 64, p.w1 + ws, DM, 16, t / 32, t % 32, smem);
  } else if (PH == 9) {
    const int nfull = (nb == 512) ? 1024 : mtiles * 8;
    for (int t = bid; t < nfull; t += nb)
      gemm_tile<3>(p, layer, p.u + (size_t)(t / 8) * 64 * 8192, 64, 8192, p.w2 + ws, DFF, 64, t / 8, t % 8, smem);
    if (nfull < mtiles * 8) {
      const int t = 1024 + (bid >> 3), kp = bid & 7;
      gemm_tile<4>(p, layer, p.u + ((size_t)(t / 8) * 64 + kp * 8) * 8192, 64, 8192, p.w2 + ws + kp * 512, DFF, 8, t / 8, t % 8, smem);
    }
  } else if (PH == 10) {
    for (int t = bid; t < 2048; t += nb) final_tile(p, t);
  }
}

#define CEN_OFF (XCD_BAR_WORDS + 512)
#define CEN_WORDS 8704
__global__ void __launch_bounds__(256, 2) mega_kernel(Params p) {
  __shared__ __attribute__((aligned(16))) char smem[SMEM_BYTES];
  __shared__ uint4 xb_words;
  __shared__ int role_words[4];
  cg::grid_group grid = cg::this_grid();
  unsigned* cen = p.bar + CEN_OFF;
  unsigned key = 0, slot = 0;
  if (threadIdx.x == 0) {
    xb_words = make_uint4(0u, 0u, 0u, 0u);
    const unsigned hwid = (unsigned)__builtin_amdgcn_s_getreg((31 << 11) | 4);
    key = ((xb_xcc_id() & 15u) << 8) | (((hwid >> 13) & 7u) << 5) | (((hwid >> 12) & 1u) << 4) | ((hwid >> 8) & 15u);
    slot = xb_add(&cen[key], 1u);
    if (slot == 0u) { const unsigned r = xb_add(&cen[4096], 1u); __hip_atomic_store(&cen[4100 + key], r, __ATOMIC_RELAXED, __HIP_MEMORY_SCOPE_AGENT); }
  }
  __syncthreads();
  XcdBarrier xb = xcd_barrier_post(p.bar, (volatile LAS unsigned*)&xb_words);
  run_phase<0>(p, 0, smem);
  if (p.bar == nullptr) grid.sync();
  xcd_barrier(xb);
  if (threadIdx.x == 0 && xb_ld(&cen[key]) != 2u) xb_add(&cen[4097], 1u);
  int role = -1, ridx = 0;
#pragma unroll 1
  for (int layer = 0; layer < DEPTH; ++layer) {
    run_phase<1>(p, layer, smem); xcd_barrier(xb);
    if (layer == 0) {
      if (threadIdx.x == 0) {
        const unsigned bad = xb_ld(&cen[4097]), ncu = xb_ld(&cen[4096]), rank = xb_ld(&cen[4100 + key]);
        int r = -1, ri = 0;
        if (bad == 0u && gridDim.x == 512u && ncu == 256u && rank < 256u && slot < 2u) {
          if (rank < (unsigned)NSCAN) { r = (slot == 0u) ? 0 : 1; ri = (int)rank; }
          else { r = 2; ri = (int)(rank - NSCAN) * 2 + (int)slot; }
        }
        role_words[0] = r; role_words[1] = ri;
      }
      __syncthreads();
      role = role_words[0]; ridx = role_words[1];
    }
    run_phase<2>(p, layer, smem); xcd_barrier(xb);
    run_phase<3>(p, layer, smem); xcd_barrier(xb);
    run_phase<4>(p, layer, smem, role, ridx); xcd_barrier(xb);
    run_phase<5>(p, layer, smem); xcd_barrier(xb);
    run_phase<6>(p, layer, smem); xcd_barrier(xb);
    run_phase<7>(p, layer, smem); xcd_barrier(xb);
    run_phase<8>(p, layer, smem); xcd_barrier(xb);
    run_phase<9>(p, layer, smem); xcd_barrier(xb);
  }
  run_phase<10>(p, 0, smem);
}

extern "C" void kernel_launch(void* const* d_in, const int* in_sizes, int n_in, void* d_out, int out_size, void* d_ws, size_t ws_size,
                              hipStream_t stream) {
  Params p{};
  const float* const* in = (const float* const*)d_in;
  p.x = in[0]; p.c = in[1]; p.ctx = in[2]; p.c_ctx = in[3]; p.ada_w = in[4]; p.ada_b = in[5]; p.norm1_g = in[6]; p.norm2_g = in[7];
  p.w_in = in[8]; p.w_out = in[9]; p.rw_w0 = in[10]; p.rw_w2 = in[11]; p.rw_a0 = in[12]; p.rw_a2 = in[13]; p.rw_kk = in[14];
  p.rw_ka = in[15]; p.rw_rk = in[16]; p.rw_g2 = in[17]; p.rw_gnw = in[18]; p.rw_gnb = in[19]; p.na_rpb = in[20]; p.q_gain = in[21];
  p.k_gain = in[22]; p.pool_w = in[23]; p.pool_scale = in[24]; p.mlp_w1 = in[25]; p.mlp_w2 = in[26]; p.final_g = in[27];
  p.out = (float*)d_out;
  char* ws = (char*)d_ws;
  size_t off = 0;
  auto take = [&](size_t bytes) { char* r = ws + off; off += (bytes + 255) & ~(size_t)255; return r; };
  p.mod = (float*)take((size_t)DEPTH * 5 * 6144 * 4);
  p.rope = (float*)take(64 * 16 * 2 * 4);
  p.xc = (float*)take((size_t)NCTX * DM * 4);
  p.hm = (u16*)take((size_t)NTOK * DM * 2);
  p.win = (u16*)take(2 * WSET * 2);
  p.wout = p.win + (size_t)DINP * DM;
  p.w1 = p.wout + (size_t)DM * DM;
  p.w2 = p.w1 + (size_t)DFF * DM;
  p.yf = (float*)take((size_t)NTOK * 256 * 4);
  p.yb = (float*)take((size_t)NTOK * 256 * 4);
  p.qb = (u16*)take((size_t)NB * 4 * SALL * 64 * 2);
  p.kb = (u16*)take((size_t)NB * 4 * SALL * 64 * 2);
  p.vtb = (u16*)take((size_t)NB * 4 * SALL * 64 * 2);
  p.qc = (u16*)take((size_t)NB * 4 * SALL * 64 * 2);
  p.kc = (u16*)take((size_t)NB * 2 * SALL * 64 * 2);
  p.vtc = (u16*)take((size_t)NB * 2 * SALL * 64 * 2);
  char* big = ws + off;
  p.u = (u16*)big;
  p.pa = (float*)take((size_t)NTOK * PAW * 4);
  p.pb = (u16*)take((size_t)NTOK * PBW * 2);
  p.decf = (float*)take((size_t)NTOK * 256 * 4);
  p.decb = (float*)take((size_t)NTOK * 256 * 4);
  p.af = (float*)take((size_t)NTOK * 256 * 4);
  p.ab = (float*)take((size_t)NTOK * 256 * 4);
  p.kk = (float*)take((size_t)NTOK * 256 * 4);
  p.bon = (float*)take((size_t)NTOK * 4 * 4);
  p.bar = (unsigned*)take((XCD_BAR_WORDS + 512 + CEN_WORDS) * 4);
  if (off > ws_size) { fprintf(stderr, "workspace too small: need %zu have %zu\n", off, ws_size); return; }
  static int grid_blocks = 0;
  if (!grid_blocks) {
    int dev = 0, cus = 0, per_cu = 0;
    hipGetDevice(&dev);
    hipDeviceGetAttribute(&cus, hipDeviceAttributeMultiprocessorCount, dev);
    hipOccupancyMaxActiveBlocksPerMultiprocessor(&per_cu, mega_kernel, 256, 0);
    per_cu = 2;
    grid_blocks = cus * per_cu;
  }
  hipMemsetAsync(p.bar, 0, (XCD_BAR_WORDS + 512 + CEN_WORDS) * 4, stream);
  void* args[] = {&p};
  hipError_t e = hipLaunchCooperativeKernel((void*)mega_kernel, dim3(grid_blocks), dim3(256), args, 0, stream);
  if (e != hipSuccess) fprintf(stderr, "cooperative launch failed: %s (grid %d)\n", hipGetErrorString(e), grid_blocks);
}
```

```cpp
#include <hip/hip_runtime.h>
#include <hip/hip_cooperative_groups.h>
#include <cstdio>
namespace cg = cooperative_groups;

#ifndef KPL
#define KPL 4
#endif

#define DI __device__ __forceinline__
typedef unsigned short u16;
typedef short bf16x8 __attribute__((ext_vector_type(8)));
typedef float f32x16 __attribute__((ext_vector_type(16)));
typedef unsigned u32x4 __attribute__((ext_vector_type(4)));
typedef __bf16 bf16x2_t __attribute__((ext_vector_type(2)));
typedef float f32x2_t __attribute__((ext_vector_type(2)));

constexpr int NB = 4, SEQ = 4096, DM = 1024, DEPTH = 4, CTXL = 256;
constexpr int NLAT = NB * SEQ, NCTX = NB * CTXL, NTOK = NLAT + NCTX, SALL = SEQ + CTXL;
constexpr int DIN = 2496, DINP = 2560, PAW = 960, PBW = 1536, DFF = 4096;
constexpr float QSCALE = 0.125f * 1.4426950408889634f;
constexpr float LOG2E = 1.4426950408889634f;
constexpr int SMEM_BYTES = 65536;
constexpr size_t WSET = (size_t)DINP * DM + (size_t)DM * DM + 2 * (size_t)DFF * DM;

struct Params {
  const float *x, *c, *ctx, *c_ctx, *ada_w, *ada_b, *norm1_g, *norm2_g, *w_in, *w_out;
  const float *rw_w0, *rw_w2, *rw_a0, *rw_a2, *rw_kk, *rw_ka, *rw_rk, *rw_g2, *rw_gnw, *rw_gnb;
  const float *na_rpb, *q_gain, *k_gain, *pool_w, *pool_scale, *mlp_w1, *mlp_w2, *final_g;
  float *out;
  float *mod, *rope, *xc, *pa, *decf, *decb, *af, *ab, *kk, *bon, *yf, *yb;
  u16 *hm, *win, *wout, *w1, *w2, *pb, *u, *qb, *kb, *vtb, *qc, *kc, *vtc;
  unsigned* bar;
};

DI unsigned pack2(float a, float b) {
  f32x2_t v = {a, b};
  bf16x2_t r = __builtin_convertvector(v, bf16x2_t);
  return __builtin_bit_cast(unsigned, r);
}
DI float bf2f(u16 v) { return __uint_as_float(((unsigned)v) << 16); }
DI float bflo(unsigned v) { return __uint_as_float(v << 16); }
DI float bfhi(unsigned v) { return __uint_as_float(v & 0xffff0000u); }
template <int CTRL> DI float dpp_add(float x) {
  int y = __builtin_amdgcn_update_dpp(0, __builtin_bit_cast(int, x), CTRL, 0xf, 0xf, true);
  return x + __builtin_bit_cast(float, y);
}
DI float wave_sum(float v) {
  v = dpp_add<0xB1>(v);
  v = dpp_add<0x4E>(v);
  v = dpp_add<0x141>(v);
  v = dpp_add<0x140>(v);
  const int iv = __builtin_bit_cast(int, v);
  const float s0 = __builtin_bit_cast(float, __builtin_amdgcn_readlane(iv, 0));
  const float s1 = __builtin_bit_cast(float, __builtin_amdgcn_readlane(iv, 16));
  const float s2 = __builtin_bit_cast(float, __builtin_amdgcn_readlane(iv, 32));
  const float s3 = __builtin_bit_cast(float, __builtin_amdgcn_readlane(iv, 48));
  return (s0 + s1) + (s2 + s3);
}
template <class T> DI T* launder(T* q) { asm volatile("" : "+v"(q)); return q; }
DI int TID() { int t = threadIdx.x; asm volatile("" : "+v"(t)); return t; }
DI int modrow(int m) { return m < NLAT ? (m >> 12) : 4; }


#define XB_TMO      128
#define XB_XCNT(j)  (256  + 64 * (j))
#define XB_XSUB(j)  (1280 + 64 * (j))
#define XB_XGEN(j)  (2304 + 64 * (j))
#define XB_TOP      3328
#define XB_TOPGEN   3392
#define XCD_BAR_WORDS 3456
#define XB_SPIN_CAP (1u << 18)
#define LAS __attribute__((address_space(3)))
DI unsigned xb_ld(unsigned* p)              { return __hip_atomic_load(p, __ATOMIC_RELAXED, __HIP_MEMORY_SCOPE_AGENT); }
DI unsigned xb_add(unsigned* p, unsigned v) { return __hip_atomic_fetch_add(p, v, __ATOMIC_RELAXED, __HIP_MEMORY_SCOPE_AGENT); }
DI unsigned xb_xcc_id() { return (unsigned)__builtin_amdgcn_s_getreg((3 << 11) | 20) & 0xFu; }
#define XB_SPIN(cond, bar) do { unsigned _sp = 0; while (cond) { __builtin_amdgcn_s_sleep(1); \
    if ((++_sp & 255u) == 0u) { if (xb_ld(&(bar)[XB_TMO])) break; if (_sp > XB_SPIN_CAP) { atomicAdd(&(bar)[XB_TMO], 1u); break; } } } } while (0)
struct XcdBarrier { unsigned* bar; unsigned x; volatile LAS unsigned* st; };
DI XcdBarrier xcd_barrier_post(unsigned* bar, volatile LAS unsigned* st) {
  XcdBarrier b; b.bar = bar; b.x = xb_xcc_id(); b.st = st;
  if (threadIdx.x == 0) (void)xb_add(&bar[XB_XCNT(b.x)], 1u);
  return b;
}
DI void xcd_barrier_complete(unsigned* bar, unsigned x, unsigned& nloc, unsigned& nx) {
  const unsigned G = gridDim.x * gridDim.y * gridDim.z;
  unsigned sum, cnt, mine, sp = 0u;
  for (;;) {
    sum = 0u; cnt = 0u; mine = 0u;
#pragma unroll
    for (unsigned j = 0; j < 16; ++j) { const unsigned c = xb_ld(&bar[XB_XCNT(j)]); sum += c; cnt += (c > 0u) ? 1u : 0u; mine = (j == x) ? c : mine; }
    if (sum == G) break;
    __builtin_amdgcn_s_sleep(1);
    if ((++sp & 255u) == 0u) { if (xb_ld(&bar[XB_TMO])) break; if (sp > XB_SPIN_CAP) { atomicAdd(&bar[XB_TMO], 1u); break; } }
  }
  nloc = mine > 0u ? mine : 1u; nx = cnt > 0u ? cnt : 1u;
}
DI void xcd_barrier(const XcdBarrier& b) {
  asm volatile("s_waitcnt vmcnt(0)" ::: "memory");
  __syncthreads();
  if (threadIdx.x == 0) {
    unsigned* bar = b.bar;
    __builtin_amdgcn_s_waitcnt(0);
    unsigned nloc = b.st[0], nx = b.st[1];
    if (nloc == 0u) { xcd_barrier_complete(bar, b.x, nloc, nx); b.st[0] = nloc; b.st[1] = nx; }
    const unsigned old = xb_add(&bar[XB_XSUB(b.x)], 1u);
    const unsigned gen = old / nloc;
    if (old + 1u == (gen + 1u) * nloc) {
      __builtin_amdgcn_fence(__ATOMIC_RELEASE, "agent");
      asm volatile("s_waitcnt vmcnt(0)" ::: "memory");
      const unsigned og = xb_add(&bar[XB_TOP], 1u);
      const unsigned tg = og / nx;
      if (og + 1u == (tg + 1u) * nx) xb_add(&bar[XB_TOPGEN], 1u);
      else XB_SPIN(xb_ld(&bar[XB_TOPGEN]) == tg, bar);
      __builtin_amdgcn_fence(__ATOMIC_ACQUIRE, "agent");
      xb_add(&bar[XB_XGEN(b.x)], 1u);
      asm volatile("s_waitcnt vmcnt(0)" ::: "memory");
    } else {
      XB_SPIN(xb_ld(&bar[XB_XGEN(b.x)]) == gen, bar);
      __builtin_amdgcn_fence(__ATOMIC_ACQUIRE, "agent");
      asm volatile("s_waitcnt vmcnt(0)" ::: "memory");
    }
  }
  __syncthreads();
}

DI void setup_tile(const Params& p, int t, char* smem) {
  const int tid = TID();
  if (t < 384) {
    const int layer = t / 96, jt = t % 96;
    float* s = (float*)smem;
    for (int i = tid; i < 5 * 1024; i += 256) {
      int r = i >> 10, k = i & 1023;
      float v = (r < 4) ? p.c[r * 1024 + k] : p.c_ctx[k];
      s[i] = v / (1.f + expf(-v));
    }
    __syncthreads();
    const int jl = tid & 63, kg = tid >> 6;
    const int j = jt * 64 + jl;
    const float* w = p.ada_w + (size_t)layer * 1024 * 6144 + j;
    float acc[5] = {0.f, 0.f, 0.f, 0.f, 0.f};
#pragma unroll 16
    for (int k = kg * 256; k < kg * 256 + 256; k += 4) {
      const float w0 = w[(size_t)k * 6144], w1 = w[(size_t)(k + 1) * 6144], w2 = w[(size_t)(k + 2) * 6144], w3 = w[(size_t)(k + 3) * 6144];
#pragma unroll
      for (int r = 0; r < 5; ++r) {
        const float4 sv = *(const float4*)(s + r * 1024 + k);
        acc[r] += sv.x * w0 + sv.y * w1 + sv.z * w2 + sv.w * w3;
      }
    }
    float* red = s + 5 * 1024;
#pragma unroll
    for (int r = 0; r < 5; ++r) red[(kg * 5 + r) * 64 + jl] = acc[r];
    __syncthreads();
    if (tid < 64) {
#pragma unroll
      for (int r = 0; r < 5; ++r) {
        float v = red[(0 * 5 + r) * 64 + tid] + red[(1 * 5 + r) * 64 + tid] + red[(2 * 5 + r) * 64 + tid] + red[(3 * 5 + r) * 64 + tid];
        p.mod[(size_t)(layer * 5 + r) * 6144 + j] = v + p.ada_b[layer * 6144 + j];
      }
    }
    __syncthreads();
  } else {
    for (int i = tid; i < 1024; i += 256) {
      int pos = i >> 4, f = i & 15;
      float invf = exp2f(-(float)f * (13.287712379549449f / 16.f));
      float ang = (float)pos * invf;
      float kf = rintf(ang * 0.15915494309189535f);
      float r = fmaf(-kf, 6.28125f, ang);
      r = fmaf(-kf, 1.9353071795864769e-3f, r);
      p.rope[i * 2] = cosf(r);
      p.rope[i * 2 + 1] = sinf(r);
    }
  }
}

DI void convert_tile(const float* src, u16* dst, int K, int N, int kt, int nt, char* smem) {
  const int tid = TID();
  float* tile = (float*)smem;
  const int k0 = kt * 64, n0 = nt * 64;
#pragma unroll
  for (int j = 0; j < 4; ++j) {
    int kr = (tid >> 4) + 16 * j, nc = (tid & 15) * 4;
    float4 v = make_float4(0.f, 0.f, 0.f, 0.f);
    if (n0 + nc < N) v = *(const float4*)(src + (size_t)(k0 + kr) * N + n0 + nc);
    tile[kr * 65 + nc + 0] = v.x; tile[kr * 65 + nc + 1] = v.y; tile[kr * 65 + nc + 2] = v.z; tile[kr * 65 + nc + 3] = v.w;
  }
  __syncthreads();
#pragma unroll
  for (int j = 0; j < 2; ++j) {
    int n = (tid >> 3) + 32 * j, k8 = (tid & 7) * 8;
    uint4 o;
    o.x = pack2(tile[(k8 + 0) * 65 + n], tile[(k8 + 1) * 65 + n]);
    o.y = pack2(tile[(k8 + 2) * 65 + n], tile[(k8 + 3) * 65 + n]);
    o.z = pack2(tile[(k8 + 4) * 65 + n], tile[(k8 + 5) * 65 + n]);
    o.w = pack2(tile[(k8 + 6) * 65 + n], tile[(k8 + 7) * 65 + n]);
    *(uint4*)(dst + (size_t)(n0 + n) * K + k0 + k8) = o;
  }
  __syncthreads();
}

DI const float* xrow_ptr(const Params& p, int layer, int m) {
  if (layer == 0) return m < NLAT ? p.x + (size_t)m * DM : p.ctx + (size_t)(m - NLAT) * DM;
  return m < NLAT ? p.out + (size_t)m * DM : p.xc + (size_t)(m - NLAT) * DM;
}
DI float* xrow_out(const Params& p, int m) {
  return m < NLAT ? p.out + (size_t)m * DM : p.xc + (size_t)(m - NLAT) * DM;
}
DI void norm_tile(const Params& p, int layer, int which, int t) {
  const int tid_ = TID(); const int wv = tid_ >> 6, lane = tid_ & 63;
  const int m = t * 8 + wv * 2;
  const float* xa = which == 0 ? xrow_ptr(p, layer, m) : xrow_out(p, m);
  const float* xb = xa + DM;
  const float* g = (which == 0 ? p.norm1_g : p.norm2_g) + layer * DM;
  const float* shift = p.mod + (size_t)(layer * 5 + modrow(m)) * 6144 + (which ? 3 * DM : 0);
  const float* scale = shift + DM;
  float4 va[4], vb[4], g4[4], sh[4], sc[4];
#pragma unroll
  for (int j = 0; j < 4; ++j) { va[j] = ((const float4*)xa)[lane + 64 * j]; vb[j] = ((const float4*)xb)[lane + 64 * j]; }
#pragma unroll
  for (int j = 0; j < 4; ++j) { g4[j] = ((const float4*)g)[lane + 64 * j]; sh[j] = ((const float4*)shift)[lane + 64 * j]; sc[j] = ((const float4*)scale)[lane + 64 * j]; }
  if (which == 0 && layer == 0) {
    float* ca = xrow_out(p, m);
#pragma unroll
    for (int j = 0; j < 4; ++j) { ((float4*)ca)[lane + 64 * j] = va[j]; ((float4*)(ca + DM))[lane + 64 * j] = vb[j]; }
  }
  float ssa = 0.f, ssb = 0.f;
#pragma unroll
  for (int j = 0; j < 4; ++j) {
    ssa += va[j].x * va[j].x + va[j].y * va[j].y + va[j].z * va[j].z + va[j].w * va[j].w;
    ssb += vb[j].x * vb[j].x + vb[j].y * vb[j].y + vb[j].z * vb[j].z + vb[j].w * vb[j].w;
  }
  ssa = wave_sum(ssa);
  ssb = wave_sum(ssb);
  const float ra = rsqrtf(ssa * (1.f / 1024.f) + 1e-6f), rb = rsqrtf(ssb * (1.f / 1024.f) + 1e-6f);
  u16* oa = p.hm + (size_t)m * DM;
#pragma unroll
  for (int j = 0; j < 4; ++j) {
    const int i4 = lane + 64 * j;
    uint2 o;
    o.x = pack2((va[j].x * ra * g4[j].x) * (1.f + sc[j].x) + sh[j].x, (va[j].y * ra * g4[j].y) * (1.f + sc[j].y) + sh[j].y);
    o.y = pack2((va[j].z * ra * g4[j].z) * (1.f + sc[j].z) + sh[j].z, (va[j].w * ra * g4[j].w) * (1.f + sc[j].w) + sh[j].w);
    ((uint2*)oa)[i4] = o;
    o.x = pack2((vb[j].x * rb * g4[j].x) * (1.f + sc[j].x) + sh[j].x, (vb[j].y * rb * g4[j].y) * (1.f + sc[j].y) + sh[j].y);
    o.y = pack2((vb[j].z * rb * g4[j].z) * (1.f + sc[j].z) + sh[j].z, (vb[j].w * rb * g4[j].w) * (1.f + sc[j].w) + sh[j].w);
    ((uint2*)(oa + DM))[i4] = o;
  }
}

template <int EPI>
DI void gemm_tile(const Params& p, int layer, const u16* __restrict__ A0, int a_rs, int a_ks, const u16* __restrict__ Bt, int K, int KT, int mt, int nt, char* smem) {
  const int tid = TID(), wv = tid >> 6, lane = tid & 63, l31 = lane & 31, h = lane >> 5;
  const int wm = wv >> 1, wn = wv & 1;
  const int m0 = mt * 128, n0 = nt * 128;
  f32x16 acc[2][2];
#pragma unroll
  for (int i = 0; i < 2; ++i)
#pragma unroll
    for (int j = 0; j < 2; ++j)
#pragma unroll
      for (int r = 0; r < 16; ++r) acc[i][j][r] = 0.f;
  const int lrow = tid >> 3, lch = tid & 7;
  const u16* ag = A0 + (size_t)lrow * a_rs + lch * 8;
  const u16* bg = Bt + (size_t)(n0 + lrow) * K + lch * 8;
  u32x4 ra0[4], rb0[4], ra1[4], rb1[4];
  char* As = smem;
  char* Bs = smem + 32768;
  auto g_load = [&](u32x4 (&RA)[4], u32x4 (&RB)[4], int kti) __attribute__((always_inline)) {
#pragma unroll
    for (int j = 0; j < 4; ++j) {
      RA[j] = *(const u32x4*)(ag + (size_t)(32 * j) * a_rs + (size_t)kti * a_ks);
      RB[j] = *(const u32x4*)(bg + (size_t)(32 * j) * K + kti * 64);
    }
  };
  auto g_store = [&](const u32x4 (&RA)[4], const u32x4 (&RB)[4], int buf) __attribute__((always_inline)) {
#pragma unroll
    for (int j = 0; j < 4; ++j) {
      int row = lrow + 32 * j;
      int off = buf * 16384 + row * 128 + ((lch ^ ((row >> 1) & 7)) << 4);
      *(u32x4*)(As + off) = RA[j];
      *(u32x4*)(Bs + off) = RB[j];
    }
  };
  auto g_frag = [&](bf16x8 (&fa)[2], bf16x8 (&fb)[2], const char* as, const char* bs, int kk) __attribute__((always_inline)) {
    const int chunk = kk * 2 + h;
#pragma unroll
    for (int i = 0; i < 2; ++i) {
      int row = wm * 64 + i * 32 + l31;
      fa[i] = *(const bf16x8*)(as + row * 128 + ((chunk ^ ((row >> 1) & 7)) << 4));
      int rowb = wn * 64 + i * 32 + l31;
      fb[i] = *(const bf16x8*)(bs + rowb * 128 + ((chunk ^ ((rowb >> 1) & 7)) << 4));
    }
  };
  auto g_mma = [&](const bf16x8 (&fa)[2], const bf16x8 (&fb)[2]) __attribute__((always_inline)) {
#pragma unroll
    for (int i = 0; i < 2; ++i)
#pragma unroll
      for (int j = 0; j < 2; ++j) acc[i][j] = __builtin_amdgcn_mfma_f32_32x32x16_bf16(fa[i], fb[j], acc[i][j], 0, 0, 0);
  };
  auto g_compute = [&](int buf) __attribute__((always_inline)) {
    const char* as = As + buf * 16384;
    const char* bs = Bs + buf * 16384;
    bf16x8 fa0[2], fb0[2], fa1[2], fb1[2];
    g_frag(fa0, fb0, as, bs, 0);
    g_frag(fa1, fb1, as, bs, 1);
    __builtin_amdgcn_sched_barrier(0);
    g_mma(fa0, fb0);
    __builtin_amdgcn_sched_barrier(0);
    g_frag(fa0, fb0, as, bs, 2);
    __builtin_amdgcn_sched_barrier(0);
    g_mma(fa1, fb1);
    __builtin_amdgcn_sched_barrier(0);
    g_frag(fa1, fb1, as, bs, 3);
    __builtin_amdgcn_sched_barrier(0);
    g_mma(fa0, fb0);
    g_mma(fa1, fb1);
  };
  g_load(ra0, rb0, 0);
  g_load(ra1, rb1, 1);
  g_store(ra0, rb0, 0);
  __syncthreads();
  g_load(ra0, rb0, 2);
  for (int kt = 0; kt < KT; kt += 2) {
    g_compute(0);
    g_store(ra1, rb1, 1);
    __syncthreads();
    if (kt + 3 < KT) g_load(ra1, rb1, kt + 3);
    g_compute(1);
    if (kt + 2 < KT) g_store(ra0, rb0, 0);
    __syncthreads();
    if (kt + 4 < KT) g_load(ra0, rb0, kt + 4);
  }
  if (EPI == 1 || EPI == 3 || EPI == 5) {
    const float* gbase = p.mod + (size_t)(layer * 5 + modrow(m0)) * 6144 + ((EPI == 1) ? 2 : 5) * DM;
    float* xb = xrow_out(p, m0 + wm * 64 + 4 * h);
#pragma unroll
    for (int j = 0; j < 2; ++j) {
      const int col = n0 + wn * 64 + j * 32 + l31;
      const float gate = gbase[col] * ((EPI == 5) ? 0.0f : 1.0f);
      float xv[2][16];
#pragma unroll
      for (int i = 0; i < 2; ++i)
#pragma unroll
        for (int r = 0; r < 16; ++r) xv[i][r] = xb[(size_t)(i * 32 + (r & 3) + 8 * (r >> 2)) * DM + col];
#pragma unroll
      for (int i = 0; i < 2; ++i)
#pragma unroll
        for (int r = 0; r < 16; ++r) xb[(size_t)(i * 32 + (r & 3) + 8 * (r >> 2)) * DM + col] = xv[i][r] + gate * acc[i][j][r];
    }
    return;
  }
#pragma unroll
  for (int i = 0; i < 2; ++i) {
#pragma unroll
    for (int j = 0; j < 2; ++j) {
      const int col = n0 + wn * 64 + j * 32 + l31;
#pragma unroll
      for (int r = 0; r < 16; ++r) {
        const int row = m0 + wm * 64 + i * 32 + (r & 3) + 8 * (r >> 2) + 4 * h;
        const float v = acc[i][j][r];
        if (EPI == 0) {
          if (col < PAW) p.pa[(size_t)row * PAW + col] = v;
          else if (col < DIN) p.pb[(size_t)row * PBW + (col - PAW)] = (u16)(pack2(v, 0.f) & 0xffff);
        } else if (EPI == 4) {
          float* xo = xrow_out(p, row);
          const float gate = p.mod[(size_t)(layer * 5 + modrow(row)) * 6144 + 5 * DM + col];
          atomicAdd(xo + col, gate * v);
        } else {
          float rl = fmaxf(v, 0.f);
          p.u[((size_t)((row >> 7) * 64 + (col >> 6)) * 128 + (row & 127)) * 64 + (col & 63)] = (u16)(pack2(rl * rl, 0.f) & 0xffff);
        }
      }
    }
  }
}

DI float fsigmoid(float x) { return __builtin_amdgcn_rcpf(1.f + __builtin_amdgcn_exp2f(-x * LOG2E)); }
constexpr int PTOK = 34;
DI void rwkv_prep_tile(const Params& p, int layer, int t, char* smem) {
  const int tid = TID(), lane = tid & 63, wv = tid >> 6;
  const int m0 = t * PTOK, j = tid;
  float* lo = (float*)smem;
  for (int i = tid; i < PTOK * 128; i += 256) {
    int tok = i >> 7, cc = i & 127;
    float v = p.pa[(size_t)(m0 + tok) * PAW + 768 + cc];
    if (cc < 64) v = 2.f * fsigmoid(2.f * v) - 1.f;
    lo[i] = v;
  }
  const float kkc = p.rw_kk[layer * 256 + j], kac = p.rw_ka[layer * 256 + j], rkc = p.rw_rk[layer * 256 + j];
  __syncthreads();
  {
    float wf[32], wb[32];
    const float* wq = launder(p.rw_w2 + (size_t)(layer * 2 * 32) * 256 + j);
#pragma unroll
    for (int k = 0; k < 32; ++k) {
      wf[k] = wq[k * 256];
      wb[k] = wq[(32 + k) * 256];
    }
    const float w0f = p.rw_w0[(layer * 2 + 0) * 256 + j], w0b = p.rw_w0[(layer * 2 + 1) * 256 + j];
#pragma unroll 1
    for (int tok = 0; tok < PTOK; ++tok) {
      float d0 = w0f, d1 = w0b;
      const float4* l4 = (const float4*)(lo + tok * 128);
#pragma unroll
      for (int k4 = 0; k4 < 8; ++k4) {
        float4 x0 = l4[k4], x1 = l4[8 + k4];
        d0 += x0.x * wf[4 * k4] + x0.y * wf[4 * k4 + 1] + x0.z * wf[4 * k4 + 2] + x0.w * wf[4 * k4 + 3];
        d1 += x1.x * wb[4 * k4] + x1.y * wb[4 * k4 + 1] + x1.z * wb[4 * k4 + 2] + x1.w * wb[4 * k4 + 3];
      }
      const size_t m = (size_t)(m0 + tok);
      p.decf[m * 256 + j] = __builtin_amdgcn_exp2f(-0.60653066f * LOG2E * fsigmoid(d0));
      p.decb[m * 256 + j] = __builtin_amdgcn_exp2f(-0.60653066f * LOG2E * fsigmoid(d1));
    }
  }
  {
    float a_f[32], a_b[32];
    const float* aq = launder(p.rw_a2 + (size_t)(layer * 2 * 32) * 256 + j);
#pragma unroll
    for (int k = 0; k < 32; ++k) {
      a_f[k] = aq[k * 256];
      a_b[k] = aq[(32 + k) * 256];
    }
    const float a0f = p.rw_a0[(layer * 2 + 0) * 256 + j], a0b = p.rw_a0[(layer * 2 + 1) * 256 + j];
#pragma unroll 1
    for (int tok = 0; tok < PTOK; ++tok) {
      float d2 = a0f, d3 = a0b;
      const float4* l4 = (const float4*)(lo + tok * 128);
#pragma unroll
      for (int k4 = 0; k4 < 8; ++k4) {
        float4 x2 = l4[16 + k4], x3 = l4[24 + k4];
        d2 += x2.x * a_f[4 * k4] + x2.y * a_f[4 * k4 + 1] + x2.z * a_f[4 * k4 + 2] + x2.w * a_f[4 * k4 + 3];
        d3 += x3.x * a_b[4 * k4] + x3.y * a_b[4 * k4 + 1] + x3.z * a_b[4 * k4 + 2] + x3.w * a_b[4 * k4 + 3];
      }
      const float af = fsigmoid(d2);
      const float ab = fsigmoid(d3);
      const size_t m = (size_t)(m0 + tok);
      const float r = p.pa[m * PAW + j], k = p.pa[m * PAW + 256 + j];
      const float kr = k * kkc;
      const float ss = wave_sum(kr * kr);
      const float kkn = kr * rsqrtf(fmaxf(ss, 1e-24f));
      const float kmf = k * (1.f + (af - 1.f) * kac), kmb = k * (1.f + (ab - 1.f) * kac);
      const float bs = wave_sum(r * (kmf + kmb) * rkc);
      p.af[m * 256 + j] = af; p.ab[m * 256 + j] = ab; p.kk[m * 256 + j] = kkn;
      if (lane == 0) p.bon[m * 4 + wv] = bs;
    }
  }
  __syncthreads();
}

DI void attn_prep_tile(const Params& p, int layer, int t, char* smem) {
  const int tid = TID();
  const int m0 = t * 64;
  int b, pos0, islat, grow;
  if (m0 < NLAT) { b = m0 >> 12; int tl = m0 & 4095; pos0 = CTXL + tl; islat = 1; grow = tl >> 6; }
  else { b = (m0 - NLAT) >> 8; pos0 = (m0 - NLAT) & 255; islat = 0; grow = 0; }
  const int tok = tid >> 2, c = tid & 3;
  const size_t m = (size_t)(m0 + tok);
  u16* T = (u16*)smem;
#pragma unroll 1
  for (int s = 0; s < 20; ++s) {
    const u16* src = p.pb + m * PBW + s * 64 + c * 16;
    uint4 r0 = *(const uint4*)src, r1 = *(const uint4*)(src + 8);
    float x[16];
    x[0] = bflo(r0.x); x[1] = bfhi(r0.x); x[2] = bflo(r0.y); x[3] = bfhi(r0.y);
    x[4] = bflo(r0.z); x[5] = bfhi(r0.z); x[6] = bflo(r0.w); x[7] = bfhi(r0.w);
    x[8] = bflo(r1.x); x[9] = bfhi(r1.x); x[10] = bflo(r1.y); x[11] = bfhi(r1.y);
    x[12] = bflo(r1.z); x[13] = bfhi(r1.z); x[14] = bflo(r1.w); x[15] = bfhi(r1.w);
    const bool isv = (s >= 8 && s < 12) || s >= 18;
    if (!isv) {
      u16* dst;
      float scl = 1.f;
      if (s < 4) { dst = p.qb + ((size_t)(b * 4 + s) * SALL + pos0 + tok) * 64; scl = QSCALE; }
      else if (s < 8) { dst = p.kb + ((size_t)(b * 4 + (s - 4)) * SALL + pos0 + tok) * 64; }
      else if (s < 16) { dst = p.qc + ((size_t)(b * 4 + (s - 12)) * SALL + pos0 + tok) * 64; scl = QSCALE; }
      else { dst = p.kc + ((size_t)(b * 2 + (s - 16)) * SALL + pos0 + tok) * 64; }
      if (s >= 12) {
        float ss = 0.f;
#pragma unroll
        for (int i = 0; i < 16; ++i) ss += x[i] * x[i];
        ss = dpp_add<0xB1>(ss);
        ss = dpp_add<0x4E>(ss);
        const float rstd = rsqrtf(ss * (1.f / 64.f) + 1e-6f);
        const float* gn = (s < 16 ? p.q_gain : p.k_gain) + layer * 64 + c * 16;
#pragma unroll
        for (int i = 0; i < 16; ++i) x[i] = x[i] * rstd * gn[i];
        if (islat) {
          const int posv = (c & 1) ? tok : grow;
          const float sgn = (c < 2) ? -1.f : 1.f;
          const float* rt = p.rope + (size_t)posv * 32;
#pragma unroll
          for (int i = 0; i < 16; ++i) {
            float part = __builtin_bit_cast(float, __builtin_amdgcn_update_dpp(0, __builtin_bit_cast(int, x[i]), 0x4E, 0xf, 0xf, true));
            float cs = rt[2 * i], sn = rt[2 * i + 1];
            x[i] = x[i] * cs + sgn * part * sn;
          }
        }
      }
      uint4 o0, o1;
      o0.x = pack2(x[0] * scl, x[1] * scl); o0.y = pack2(x[2] * scl, x[3] * scl);
      o0.z = pack2(x[4] * scl, x[5] * scl); o0.w = pack2(x[6] * scl, x[7] * scl);
      o1.x = pack2(x[8] * scl, x[9] * scl); o1.y = pack2(x[10] * scl, x[11] * scl);
      o1.z = pack2(x[12] * scl, x[13] * scl); o1.w = pack2(x[14] * scl, x[15] * scl);
      *(uint4*)(dst + c * 16) = o0;
      *(uint4*)(dst + c * 16 + 8) = o1;
    } else {
      const unsigned wd[8] = {r0.x, r0.y, r0.z, r0.w, r1.x, r1.y, r1.z, r1.w};
#pragma unroll
      for (int i = 0; i < 8; ++i) {
        T[(c * 16 + 2 * i) * 72 + tok] = (u16)(wd[i] & 0xffffu);
        T[(c * 16 + 2 * i + 1) * 72 + tok] = (u16)(wd[i] >> 16);
      }
      __syncthreads();
      const int d = tid >> 2, ch = tid & 3;
      uint4 v0 = *(const uint4*)(T + d * 72 + ch * 16), v1 = *(const uint4*)(T + d * 72 + ch * 16 + 8);
      u16* dst = (s < 12) ? p.vtb + ((size_t)(b * 4 + (s - 8)) * 64 + d) * SALL + pos0 + ch * 16
                          : p.vtc + ((size_t)(b * 2 + (s - 18)) * 64 + d) * SALL + pos0 + ch * 16;
      *(uint4*)dst = v0;
      *(uint4*)(dst + 8) = v1;
      __syncthreads();
    }
  }
}

DI void pool_tile(const Params& p, int layer, int t, char* smem) {
  const int tid = TID(), lane = tid & 63, g = tid >> 6;
  const int m0 = t * 64;
  int tl, n, mbase;
  if (m0 < NLAT) { tl = m0 & 4095; n = SEQ; mbase = m0 - tl; }
  else { tl = (m0 - NLAT) & 255; n = CTXL; mbase = m0 - tl; }
  u16* sp = (u16*)smem;
  float* sdiff = (float*)(smem + 40960);
  for (int i = tid; i < 80 * 32; i += 256) {
    int row = i >> 5, c8 = i & 31;
    int tt = tl - 8 + row;
    if (tt >= 0 && tt < n) *(uint4*)(sp + row * 256 + c8 * 8) = *(const uint4*)(p.pb + (size_t)(mbase + tt) * PBW + 1280 + c8 * 8);
  }
  float wreg[64];
  const float* wp0 = launder(p.pool_w + (size_t)((layer * 4 + g) * 64) * 64 + lane);
#pragma unroll
  for (int cc = 0; cc < 64; ++cc) wreg[cc] = wp0[cc * 64];
  const float psc = p.pool_scale[layer * 256 + tid];
  const int w = 2 << g;
  __syncthreads();
#pragma unroll 1
  for (int sub = 0; sub < 4; ++sub) {
#pragma unroll 1
    for (int tt = 0; tt < 16; ++tt) {
      int tq = tl + sub * 16 + tt;
      int lo = max(tq - w / 2, 0), hi = min(tq - w / 2 + w, n);
      float sum = 0.f;
      for (int u = lo; u < hi; ++u) sum += bf2f(sp[(u - tl + 8) * 256 + tid]);
      float self = bf2f(sp[(tq - tl + 8) * 256 + tid]);
      sdiff[tt * 256 + tid] = sum / (float)(hi - lo) - self;
    }
    __syncthreads();
#pragma unroll 1
    for (int tt = 0; tt < 16; ++tt) {
      const float4* d4 = (const float4*)(sdiff + tt * 256 + g * 64);
      float acc = 0.f;
#pragma unroll
      for (int c4 = 0; c4 < 16; ++c4) {
        float4 dv = d4[c4];
        acc += dv.x * wreg[4 * c4] + dv.y * wreg[4 * c4 + 1] + dv.z * wreg[4 * c4 + 2] + dv.w * wreg[4 * c4 + 3];
      }
      p.hm[(size_t)(m0 + sub * 16 + tt) * DM + 768 + tid] = (u16)(pack2(acc * psc, 0.f) & 0xffff);
    }
    __syncthreads();
  }
}

template <int LPRv> DI float row_reduce(float x) {
  x = dpp_add<0xB1>(x);
  x = dpp_add<0x4E>(x);
  if (LPRv >= 8) x = dpp_add<0x141>(x);
  if (LPRv >= 16) x = dpp_add<0x140>(x);
  return x;
}
DI int scan_tok(int b, int dir, int c, int i) {
  if (c < 16) { int s = c * 16 + i; return NLAT + b * CTXL + (dir ? (CTXL - 1 - s) : s); }
  int s = (c - 16) * 16 + i;
  return b * SEQ + (dir ? (SEQ - 1 - s) : s);
}
typedef float v4f __attribute__((ext_vector_type(4)));
typedef float v2f __attribute__((ext_vector_type(2)));
#define SCAN_LD(nw, nk, nb, nm, nr, nv, aaddr, vaddr, SA, SB) asm volatile( \
    "ds_read_b128 %0, %8\n\tds_read_b128 %1, %8 offset:4096\n\tds_read_b128 %2, %8 offset:8192\n\tds_read_b128 %3, %8 offset:12288\n\tds_read_b128 %4, %8 offset:16384\n\tds_read_b32 %5, %9" \
    : "=&v"(nw), "=&v"(nk), "=&v"(nb), "=&v"(nm), "=&v"(nr), "=&v"(nv), "+v"(SA), "+v"(SB) : "v"(aaddr), "v"(vaddr))
#define SCAN_LDI(nw, nk, nb, nm, nr, nv, aaddr, vaddr, SA, SB, OFF) asm volatile( \
    "ds_read_b128 %0, %8 offset:%10\n\tds_read_b128 %1, %8 offset:%11\n\tds_read_b128 %2, %8 offset:%12\n\tds_read_b128 %3, %8 offset:%13\n\tds_read_b128 %4, %8 offset:%14\n\tds_read_b32 %5, %9 offset:%10" \
    : "=&v"(nw), "=&v"(nk), "=&v"(nb), "=&v"(nm), "=&v"(nr), "=&v"(nv), "+v"(SA), "+v"(SB) : "v"(aaddr), "v"(vaddr), \
      "n"(OFF), "n"((OFF) + 4096), "n"((OFF) + 8192), "n"((OFF) + 12288), "n"((OFF) + 16384))
#define SCAN_WAIT(nw, nk, nb, nm, nr, nv, SA, SB) asm volatile("s_waitcnt lgkmcnt(0)" : "+v"(nw), "+v"(nk), "+v"(nb), "+v"(nm), "+v"(nr), "+v"(nv), "+v"(SA), "+v"(SB))
#define SCAN_WAIT6(nw, nk, nb, nm, nr, nv, SA, SB) asm volatile("s_waitcnt lgkmcnt(6)" : "+v"(nw), "+v"(nk), "+v"(nb), "+v"(nm), "+v"(nr), "+v"(nv), "+v"(SA), "+v"(SB))
template <int CTRL> DI float dpp_mov(float x) {
  return __builtin_bit_cast(float, __builtin_amdgcn_update_dpp(0, __builtin_bit_cast(int, x), CTRL, 0xf, 0xf, true));
}
DI void scan_item(const Params& p, int layer, int sb, char* smem) {
  constexpr int LPR = 64 / KPL, RPB = 4 * KPL, BPI = 16 / KPL, YPL = 16 / LPR;
  const int tid = TID(), wv = tid >> 6, lane = tid & 63;
  const int item = sb / BPI, part = sb % BPI;
  const int b = item >> 3, hh = (item >> 1) & 3, dir = item & 1;
  const int row = part * RPB + wv * KPL + lane / LPR, kq = lane % LPR;
  const float* dec = dir ? p.decb : p.decf;
  const float* aa = dir ? p.ab : p.af;
  float* Y = dir ? p.yb : p.yf;
  const int li = tid >> 4, lf = tid & 15;
  const float4 ka4 = *(const float4*)(p.rw_ka + layer * 256 + hh * 64 + lf * 4);
  v2f SA = {0.f, 0.f}, SB = {0.f, 0.f};
  const bool c3 = (kq & 8) != 0, c2 = (kq & 4) != 0, c1 = (kq & 2) != 0, c0 = (kq & 1) != 0;
  const int sidx = (c3 ? 8 : 0) + (c2 ? 4 : 0) + (c0 ? 2 : 0) + (c1 ? 1 : 0);
  float* bufs = (float*)smem;
  const unsigned lds0 = (unsigned)(size_t)smem;
  float4 gr, gk, gv, gd, ga, gkk;
  auto gload = [&](int c) {
    size_t m = (size_t)scan_tok(b, dir, c, li);
    const float* pr = p.pa + m * PAW + hh * 64 + lf * 4;
    gr = *(const float4*)pr; gk = *(const float4*)(pr + 256); gv = *(const float4*)(pr + 512);
    size_t o = m * 256 + hh * 64 + lf * 4;
    gd = *(const float4*)(dec + o); ga = *(const float4*)(aa + o); gkk = *(const float4*)(p.kk + o);
  };
  auto lstore = [&](int bi) {
    float* bb = bufs + bi * 6144 + li * 64 + lf * 4;
    *(float4*)(bb) = gd;
    *(float4*)(bb + 1024) = gkk;
    *(float4*)(bb + 2048) = make_float4(gkk.x * ga.x, gkk.y * ga.y, gkk.z * ga.z, gkk.w * ga.w);
    *(float4*)(bb + 3072) = make_float4(gk.x * (1.f + (ga.x - 1.f) * ka4.x), gk.y * (1.f + (ga.y - 1.f) * ka4.y),
                                        gk.z * (1.f + (ga.z - 1.f) * ka4.z), gk.w * (1.f + (ga.w - 1.f) * ka4.w));
    *(float4*)(bb + 4096) = gr;
    *(float4*)(bb + 5120) = gv;
  };
  __builtin_amdgcn_s_setprio(3);
  gload(0);
  lstore(0);
  __syncthreads();
  for (int c = 0; c < 272; ++c) {
    if (c + 1 < 272) gload(c + 1);
    float yp[16];
    v4f qw[3], qk[3], qb[3], qm[3], qr[3];
    float qv[3];
    const unsigned abase = lds0 + (unsigned)(c & 1) * 24576u + (unsigned)kq * 16u;
    const unsigned vbase = lds0 + (unsigned)(c & 1) * 24576u + 20480u + (unsigned)row * 4u;
    SCAN_LDI(qw[0], qk[0], qb[0], qm[0], qr[0], qv[0], abase, vbase, SA, SB, 0);
    SCAN_LDI(qw[1], qk[1], qb[1], qm[1], qr[1], qv[1], abase, vbase, SA, SB, 256);
    SCAN_WAIT6(qw[0], qk[0], qb[0], qm[0], qr[0], qv[0], SA, SB);
#define SCAN_STEP(I) { \
      constexpr int cs = (I) % 3, ns = ((I) + 1) % 3, fs = ((I) + 2) % 3; \
      const v2f w0 = {qw[cs][0], qw[cs][1]}, w1 = {qw[cs][2], qw[cs][3]}, k0 = {qk[cs][0], qk[cs][1]}, k1 = {qk[cs][2], qk[cs][3]}; \
      const v2f b0 = {qb[cs][0], qb[cs][1]}, b1 = {qb[cs][2], qb[cs][3]}, m0 = {qm[cs][0], qm[cs][1]}, m1 = {qm[cs][2], qm[cs][3]}; \
      const v2f r0 = {qr[cs][0], qr[cs][1]}, r1 = {qr[cs][2], qr[cs][3]}; \
      const float vv = qv[cs]; \
      if ((I) + 2 < 16) { SCAN_LDI(qw[fs], qk[fs], qb[fs], qm[fs], qr[fs], qv[fs], abase, vbase, SA, SB, (((I) + 2) & 15) * 256); } \
      v2f t = SA * k0; \
      t = __builtin_elementwise_fma(SB, k1, t); \
      const float sa = row_reduce<LPR>(t[0] + t[1]); \
      const v2f nsa = {-sa, -sa}, vv2 = {vv, vv}; \
      SA = __builtin_elementwise_fma(vv2, m0, __builtin_elementwise_fma(nsa, b0, SA * w0)); \
      SB = __builtin_elementwise_fma(vv2, m1, __builtin_elementwise_fma(nsa, b1, SB * w1)); \
      v2f u = SA * r0; \
      u = __builtin_elementwise_fma(SB, r1, u); \
      yp[I] = u[0] + u[1]; \
      if ((I) + 1 < 16) { \
        if ((I) + 2 < 16) { SCAN_WAIT6(qw[ns], qk[ns], qb[ns], qm[ns], qr[ns], qv[ns], SA, SB); } \
        else { SCAN_WAIT(qw[ns], qk[ns], qb[ns], qm[ns], qr[ns], qv[ns], SA, SB); } \
      } }
    SCAN_STEP(0) SCAN_STEP(1) SCAN_STEP(2) SCAN_STEP(3) SCAN_STEP(4) SCAN_STEP(5) SCAN_STEP(6) SCAN_STEP(7)
    SCAN_STEP(8) SCAN_STEP(9) SCAN_STEP(10) SCAN_STEP(11) SCAN_STEP(12) SCAN_STEP(13) SCAN_STEP(14) SCAN_STEP(15)
#undef SCAN_STEP
    float yfin;
    {
      float q[8], r4[4], r2[2];
#pragma unroll
      for (int m = 0; m < 8; ++m) { float mine = c3 ? yp[m + 8] : yp[m]; float oth = c3 ? yp[m] : yp[m + 8]; q[m] = mine + dpp_mov<0x128>(oth); }
#pragma unroll
      for (int m = 0; m < 4; ++m) { float mine = c2 ? q[m + 4] : q[m]; float oth = c2 ? q[m] : q[m + 4]; r4[m] = mine + dpp_mov<0x141>(oth); }
#pragma unroll
      for (int m = 0; m < 2; ++m) { float mine = c0 ? r4[m + 2] : r4[m]; float oth = c0 ? r4[m] : r4[m + 2]; r2[m] = mine + dpp_mov<0xB1>(oth); }
      float mine = c1 ? r2[1] : r2[0]; float oth = c1 ? r2[0] : r2[1];
      yfin = mine + dpp_mov<0x4E>(oth);
    }
    {
      size_t m = (size_t)scan_tok(b, dir, c, sidx);
      Y[m * 256 + hh * 64 + row] = yfin;
    }
    if (c + 1 < 272) lstore((c + 1) & 1);
    __syncthreads();
  }
  __builtin_amdgcn_s_setprio(0);
}

template <int NA>
DI void attn_item(const Params& p, const u16* __restrict__ Qb, const u16* __restrict__ Kb, const u16* __restrict__ Vtb, int ntiles,
                  int mrow0, int colbase, int rp, const float* rpbh, char* smem) {
  const int tid = TID(), wv = tid >> 6, lane = tid & 63, l31 = lane & 31, h = lane >> 5;
  char* Kbuf = smem;
  char* Vbuf = smem + 16384;
  float* rpbL = (float*)(smem + 16384 + 17408);
  int rs0 = 0, nloc = 0, qr = 0, myrs = 0;
  if (NA) {
    int r0 = rp * 2, r1 = r0 + 1;
    rs0 = min(max(r0 - 4, 0), 56);
    int rs1 = min(max(r1 - 4, 0), 56);
    nloc = rs1 + 8 - rs0;
    qr = r0 + (wv >> 1);
    myrs = min(max(qr - 4, 0), 56);
    for (int i = tid; i < 465; i += 256) rpbL[i] = rpbh[i] * LOG2E;
  }
  bf16x8 qf[4];
  {
    const u16* qp = Qb + (size_t)(wv * 32 + l31) * 64 + 8 * h;
#pragma unroll
    for (int kk = 0; kk < 4; ++kk) qf[kk] = *(const bf16x8*)(qp + kk * 16);
  }
  f32x16 o[2];
#pragma unroll
  for (int dt = 0; dt < 2; ++dt)
#pragma unroll
    for (int r = 0; r < 16; ++r) o[dt][r] = 0.f;
  float mrun = -INFINITY, lsum = 0.f;
  const int lr = tid >> 2, lc = tid & 3;
  struct TileRegs { u32x4 k0, k1, v0, v1; };
  TileRegs ta, tb;
  auto tilepos = [&](int j) -> int {
    if (NA) return j < nloc ? CTXL + (rs0 + j) * 64 : (j - nloc) * 64;
    return j * 64;
  };
  auto gload = [&](TileRegs& tr, int j) __attribute__((always_inline)) {
    int pos0 = tilepos(j);
    const u16* ks = Kb + (size_t)(pos0 + lr) * 64 + lc * 16;
    tr.k0 = *(const u32x4*)ks; tr.k1 = *(const u32x4*)(ks + 8);
    const u16* vs = Vtb + (size_t)lr * SALL + pos0 + lc * 16;
    tr.v0 = *(const u32x4*)vs; tr.v1 = *(const u32x4*)(vs + 8);
  };
  auto lstore = [&](const TileRegs& tr, int bi) __attribute__((always_inline)) {
    char* kb = Kbuf + bi * 8192 + lr * 128;
    int sw = (lr >> 1) & 7;
    *(u32x4*)(kb + (((lc * 2) ^ sw) << 4)) = tr.k0;
    *(u32x4*)(kb + (((lc * 2 + 1) ^ sw) << 4)) = tr.k1;
    char* vb = Vbuf + bi * 8704 + lr * 136 + lc * 32;
    *(uint2*)(vb) = make_uint2(tr.v0[0], tr.v0[1]);
    *(uint2*)(vb + 8) = make_uint2(tr.v0[2], tr.v0[3]);
    *(uint2*)(vb + 16) = make_uint2(tr.v1[0], tr.v1[1]);
    *(uint2*)(vb + 24) = make_uint2(tr.v1[2], tr.v1[3]);
  };
  auto compute = [&](int j, int bi) __attribute__((always_inline)) {
    bool skip = false;
    int krow = 0;
    bool local = false;
    if (NA && j < nloc) { local = true; krow = rs0 + j; skip = (krow < myrs) || (krow >= myrs + 8); }
    if (!skip) {
      const char* kb = Kbuf + bi * 8192;
      const char* vb = Vbuf + bi * 8704;
      f32x16 s[2];
#pragma unroll
      for (int sub = 0; sub < 2; ++sub) {
#pragma unroll
        for (int r = 0; r < 16; ++r) s[sub][r] = 0.f;
        const int row = sub * 32 + l31;
#pragma unroll
        for (int kk = 0; kk < 4; ++kk) {
          bf16x8 a = *(const bf16x8*)(kb + row * 128 + (((kk * 2 + h) ^ ((row >> 1) & 7)) << 4));
          s[sub] = __builtin_amdgcn_mfma_f32_32x32x16_bf16(a, qf[kk], s[sub], 0, 0, 0);
        }
      }
      if (NA && local) {
        const int qc = (wv & 1) * 32 + l31;
        const int cs = min(max(qc - 8, 0), 48);
        const float* brow = rpbL + (krow - qr + 7) * 31 + 15 - qc;
#pragma unroll
        for (int sub = 0; sub < 2; ++sub)
#pragma unroll
          for (int r = 0; r < 16; ++r) {
            int kc = sub * 32 + (r & 3) + 8 * (r >> 2) + 4 * h;
            bool valid = (kc >= cs) && (kc < cs + 16);
            float bias = valid ? brow[kc] : 0.f;
            s[sub][r] = valid ? s[sub][r] + bias : -INFINITY;
          }
      }
      float mx = s[0][0];
#pragma unroll
      for (int r = 1; r < 16; ++r) mx = fmaxf(mx, s[0][r]);
#pragma unroll
      for (int r = 0; r < 16; ++r) mx = fmaxf(mx, s[1][r]);
      mx = fmaxf(mx, __shfl_xor(mx, 32));
      const float mnew = fmaxf(mrun, mx);
      const float alpha = __builtin_amdgcn_exp2f(mrun - mnew);
      mrun = mnew;
      float ps = 0.f;
#pragma unroll
      for (int sub = 0; sub < 2; ++sub)
#pragma unroll
        for (int r = 0; r < 16; ++r) { float e = __builtin_amdgcn_exp2f(s[sub][r] - mnew); s[sub][r] = e; ps += e; }
      lsum = lsum * alpha + ps;
#pragma unroll
      for (int dt = 0; dt < 2; ++dt)
#pragma unroll
        for (int r = 0; r < 16; ++r) o[dt][r] *= alpha;
#pragma unroll
      for (int sub = 0; sub < 2; ++sub) {
#pragma unroll
        for (int s16 = 0; s16 < 2; ++s16) {
          unsigned pk[4];
#pragma unroll
          for (int e = 0; e < 4; ++e) pk[e] = pack2(s[sub][8 * s16 + 2 * e], s[sub][8 * s16 + 2 * e + 1]);
          bf16x8 pb = __builtin_bit_cast(bf16x8, *(uint4*)pk);
#pragma unroll
          for (int dt = 0; dt < 2; ++dt) {
            const char* va = vb + (32 * dt + l31) * 136 + (32 * sub + 16 * s16 + 4 * h) * 2;
            uint2 v0 = *(const uint2*)va, v1 = *(const uint2*)(va + 16);
            uint4 vv = make_uint4(v0.x, v0.y, v1.x, v1.y);
            bf16x8 a = __builtin_bit_cast(bf16x8, vv);
            o[dt] = __builtin_amdgcn_mfma_f32_32x32x16_bf16(a, pb, o[dt], 0, 0, 0);
          }
        }
      }
    }
  };
  gload(ta, 0);
  if (ntiles > 1) gload(tb, 1);
  lstore(ta, 0);
  __syncthreads();
  if (ntiles > 2) gload(ta, 2);
#pragma unroll 1
  for (int j = 0; j < ntiles; j += 2) {
    compute(j, 0);
    if (j + 1 < ntiles) lstore(tb, 1);
    __syncthreads();
    if (j + 3 < ntiles) gload(tb, j + 3);
    if (j + 1 < ntiles) compute(j + 1, 1);
    if (j + 2 < ntiles) lstore(ta, 0);
    __syncthreads();
    if (j + 4 < ntiles) gload(ta, j + 4);
  }
  const float ltot = lsum + __shfl_xor(lsum, 32);
  const float inv = 1.f / ltot;
  u16* orow = p.hm + (size_t)(mrow0 + wv * 32 + l31) * DM + colbase;
#pragma unroll
  for (int dt = 0; dt < 2; ++dt)
#pragma unroll
    for (int i4 = 0; i4 < 4; ++i4) {
      int d0 = 32 * dt + 8 * i4 + 4 * h;
      uint2 ov;
      ov.x = pack2(o[dt][4 * i4] * inv, o[dt][4 * i4 + 1] * inv);
      ov.y = pack2(o[dt][4 * i4 + 2] * inv, o[dt][4 * i4 + 3] * inv);
      *(uint2*)(orow + d0) = ov;
    }
}

DI void attn_dispatch(const Params& p, int layer, int it, char* smem) {
  if (it < 512) {
    int b = it >> 7, hd = (it >> 5) & 3, qt = it & 31;
    const u16* Q = p.qc + ((size_t)(b * 4 + hd) * SALL + CTXL + qt * 128) * 64;
    const u16* K = p.kc + (size_t)(b * 2 + (hd >> 1)) * SALL * 64;
    const u16* V = p.vtc + (size_t)(b * 2 + (hd >> 1)) * 64 * SALL;
    attn_item<0>(p, Q, K, V, 68, b * SEQ + qt * 128, 512 + hd * 64, 0, nullptr, smem);
  } else if (it < 1024) {
    int i2 = it - 512;
    int b = i2 >> 7, hd = (i2 >> 5) & 3, rp = i2 & 31;
    const u16* Q = p.qb + ((size_t)(b * 4 + hd) * SALL + CTXL + rp * 128) * 64;
    const u16* K = p.kb + (size_t)(b * 4 + hd) * SALL * 64;
    const u16* V = p.vtb + (size_t)(b * 4 + hd) * 64 * SALL;
    int r0 = rp * 2;
    int rs0 = min(max(r0 - 4, 0), 56), rs1 = min(max(r0 + 1 - 4, 0), 56);
    attn_item<1>(p, Q, K, V, (rs1 + 8 - rs0) + 4, b * SEQ + rp * 128, 256 + hd * 64, rp, p.na_rpb + (size_t)(layer * 4 + hd) * 465, smem);
  } else if (it < 1056) {
    int i2 = it - 1024;
    int b = i2 >> 3, hd = (i2 >> 1) & 3, hf = i2 & 1;
    const u16* Q = p.qc + ((size_t)(b * 4 + hd) * SALL + hf * 128) * 64;
    const u16* K = p.kc + (size_t)(b * 2 + (hd >> 1)) * SALL * 64;
    const u16* V = p.vtc + (size_t)(b * 2 + (hd >> 1)) * 64 * SALL;
    attn_item<0>(p, Q, K, V, 4, NLAT + b * CTXL + hf * 128, 512 + hd * 64, 0, nullptr, smem);
  } else {
    int i2 = it - 1056;
    int b = i2 >> 3, hd = (i2 >> 1) & 3, hf = i2 & 1;
    const u16* Q = p.qb + ((size_t)(b * 4 + hd) * SALL + hf * 128) * 64;
    const u16* K = p.kb + (size_t)(b * 4 + hd) * SALL * 64;
    const u16* V = p.vtb + (size_t)(b * 4 + hd) * 64 * SALL;
    attn_item<0>(p, Q, K, V, 4, NLAT + b * CTXL + hf * 128, 256 + hd * 64, 0, nullptr, smem);
  }
}
constexpr int N_ATT_ITEMS = 1088;

DI void readout_tile(const Params& p, int layer, int t, char* smem) {
  const int tid = TID(), wv = tid >> 6;
  const int m0 = t * PTOK;
  float* sg = (float*)smem;
  for (int i = tid; i < PTOK * 64; i += 256) {
    int tok = i >> 6, k = i & 63;
    float v = p.pa[(size_t)(m0 + tok) * PAW + 896 + k];
    sg[i] = fsigmoid(v);
  }
  float g2r[64];
  const float* gq = launder(p.rw_g2 + (size_t)(layer * 64) * 256 + tid);
#pragma unroll
  for (int k = 0; k < 64; ++k) g2r[k] = gq[k * 256];
  const float gnw = p.rw_gnw[layer * 256 + tid], gnb = p.rw_gnb[layer * 256 + tid];
  __syncthreads();
#pragma unroll 1
  for (int tok = 0; tok < PTOK; ++tok) {
    const size_t m = (size_t)(m0 + tok);
    const float y = p.yf[m * 256 + tid] + p.yb[m * 256 + tid];
    const float mu = wave_sum(y) * (1.f / 64.f);
    const float d = y - mu;
    const float var = wave_sum(d * d) * (1.f / 64.f);
    const float yn = d * rsqrtf(var + 6.4e-4f) * gnw + gnb;
    const float bonus = p.bon[m * 4 + wv] * p.pa[m * PAW + 512 + tid];
    const float4* s4 = (const float4*)(sg + tok * 64);
    float gate = 0.f;
#pragma unroll
    for (int k4 = 0; k4 < 16; ++k4) {
      float4 sv = s4[k4];
      gate += sv.x * g2r[4 * k4] + sv.y * g2r[4 * k4 + 1] + sv.z * g2r[4 * k4 + 2] + sv.w * g2r[4 * k4 + 3];
    }
    p.hm[m * DM + tid] = (u16)(pack2((yn + bonus) * gate, 0.f) & 0xffff);
  }
  __syncthreads();
}

DI void final_tile(const Params& p, int t) {
  const int tid_ = TID(); const int wv = tid_ >> 6, lane = tid_ & 63;
  float* xa = p.out + (size_t)(t * 8 + wv * 2) * DM;
  float* xb = xa + DM;
  float4 va[4], vb[4], g4[4];
#pragma unroll
  for (int j = 0; j < 4; ++j) { va[j] = ((const float4*)xa)[lane + 64 * j]; vb[j] = ((const float4*)xb)[lane + 64 * j]; g4[j] = ((const float4*)p.final_g)[lane + 64 * j]; }
  float ssa = 0.f, ssb = 0.f;
#pragma unroll
  for (int j = 0; j < 4; ++j) {
    ssa += va[j].x * va[j].x + va[j].y * va[j].y + va[j].z * va[j].z + va[j].w * va[j].w;
    ssb += vb[j].x * vb[j].x + vb[j].y * vb[j].y + vb[j].z * vb[j].z + vb[j].w * vb[j].w;
  }
  ssa = wave_sum(ssa);
  ssb = wave_sum(ssb);
  const float ra = rsqrtf(ssa * (1.f / 1024.f) + 1e-6f), rb = rsqrtf(ssb * (1.f / 1024.f) + 1e-6f);
#pragma unroll
  for (int j = 0; j < 4; ++j) {
    ((float4*)xa)[lane + 64 * j] = make_float4(va[j].x * ra * g4[j].x, va[j].y * ra * g4[j].y, va[j].z * ra * g4[j].z, va[j].w * ra * g4[j].w);
    ((float4*)xb)[lane + 64 * j] = make_float4(vb[j].x * rb * g4[j].x, vb[j].y * rb * g4[j].y, vb[j].z * rb * g4[j].z, vb[j].w * rb * g4[j].w);
  }
}

constexpr int NSCAN = 32 * (16 / KPL);
DI void convert_dispatch(const Params& p, int wl, int t, char* smem) {
  const size_t ws = (size_t)(wl & 1) * WSET;
  if (t < 640) convert_tile(p.w_in + (size_t)wl * DM * DIN, p.win + ws, DM, DIN, t / 40, t % 40, smem);
  else if (t < 896) { int u = t - 640; convert_tile(p.w_out + (size_t)wl * DM * DM, p.wout + ws, DM, DM, u / 16, u % 16, smem); }
  else if (t < 1920) { int u = t - 896; convert_tile(p.mlp_w1 + (size_t)wl * DM * DFF, p.w1 + ws, DM, DFF, u / 64, u % 64, smem); }
  else { int u = t - 1920; convert_tile(p.mlp_w2 + (size_t)wl * DFF * DM, p.w2 + ws, DFF, DM, u / 16, u % 16, smem); }
}
DI void sub_barrier(unsigned* ctr, unsigned expected) {
  asm volatile("s_waitcnt vmcnt(0)" ::: "memory");
  __syncthreads();
  if (threadIdx.x == 0) {
    __builtin_amdgcn_fence(__ATOMIC_RELEASE, "agent");
    asm volatile("s_waitcnt vmcnt(0)" ::: "memory");
    xb_add(ctr, 1u);
    unsigned sp = 0;
    while (xb_ld(ctr) < expected) { __builtin_amdgcn_s_sleep(1); if (++sp > (1u << 22)) break; }
    __builtin_amdgcn_fence(__ATOMIC_ACQUIRE, "agent");
    asm volatile("s_waitcnt vmcnt(0)" ::: "memory");
  }
  __syncthreads();
}
template <int PH>
DI void run_phase(const Params& p, int layer, char* smem, int role = -1, int ridx = 0) {
  const int bid = blockIdx.x, nb = gridDim.x;
  const size_t ws = (size_t)(layer & 1) * WSET;
  const bool last = (layer == DEPTH - 1);
  const int mtiles = last ? 128 : 136;
  if (PH == 0) {
    for (int t = bid; t < 385 + 2944; t += nb) {
      if (t < 385) setup_tile(p, t, smem);
      else convert_dispatch(p, 0, t - 385, smem);
    }
  } else if (PH == 1) {
    const int nconv = 0;
    for (int t = bid; t < nconv + 2176; t += nb) {
      if (t < nconv) convert_dispatch(p, layer, t, smem);
      else norm_tile(p, layer, 0, t - nconv);
    }
  } else if (PH == 2) {
    for (int t = bid; t < 136 * 20; t += nb) gemm_tile<0>(p, layer, p.hm + (size_t)(t / 20) * 128 * DM, DM, 64, p.win + ws, DM, 16, t / 20, t % 20, smem);
  } else if (PH == 3) {
    for (int t = bid; t < 512 + 272; t += nb) {
      if (t < 512) rwkv_prep_tile(p, layer, t, smem);
      else attn_prep_tile(p, layer, t - 512, smem);
    }
  } else if (PH == 4) {
    const bool is_scan = (role >= 0) ? (role == 0) : (bid < NSCAN);
    const bool is_partner = (role == 1);
    const int nconv = (layer + 1 < DEPTH) ? 2944 : 0;
    if (is_scan) {
      scan_item(p, layer, (role >= 0) ? ridx : bid, smem);
    } else if (is_partner) {
      for (int it = ridx; it < nconv; it += NSCAN) convert_dispatch(p, layer + 1, it, smem);
    } else {
      const int ab = (role >= 0) ? ridx : bid - NSCAN, nab = (role >= 0) ? 256 : nb - NSCAN;
      const int total = N_ATT_ITEMS + 272 + ((role >= 0) ? 0 : nconv);
      for (int it = ab; it < total; it += nab) {
        if (it < N_ATT_ITEMS) { if (!(last && it >= 1024)) attn_dispatch(p, layer, it, smem); }
        else if (it < N_ATT_ITEMS + 272) { if (!(last && it - N_ATT_ITEMS >= 256)) pool_tile(p, layer, it - N_ATT_ITEMS, smem); }
        else convert_dispatch(p, layer + 1, it - N_ATT_ITEMS - 272, smem);
      }
    }
  } else if (PH == 5) {
    for (int t = bid; t < (last ? 482 : 512); t += nb) readout_tile(p, layer, t, smem);
  } else if (PH == 6) {
    for (int t = bid; t < mtiles * 8; t += nb) gemm_tile<1>(p, layer, p.hm + (size_t)(t / 8) * 128 * DM, DM, 64, p.wout + ws, DM, 16, t / 8, t % 8, smem);
  } else if (PH == 7) {
    for (int t = bid; t < mtiles * 16; t += nb) norm_tile(p, layer, 1, t);
  } else if (PH == 8) {
    for (int t = bid; t < mtiles * 32; t += nb) gemm_tile<2>(p, layer, p.hm + (size_t)(t / 32) * 128 * DM, DM, 64, p.w1 + ws, DM, 16, t / 32, t % 32, smem);
  } else if (PH == 9) {
    const int nfull = (nb == 512) ? 1024 : mtiles * 8;
    for (int t = bid; t < nfull; t += nb)
      gemm_tile<3>(p, layer, p.u + (size_t)(t / 8) * 64 * 8192, 64, 8192, p.w2 + ws, DFF, 64, t / 8, t % 8, smem);
    if (nfull < mtiles * 8) {
      const int t = 1024 + (bid >> 3), kp = bid & 7;
      gemm_tile<4>(p, layer, p.u + ((size_t)(t / 8) * 64 + kp * 8) * 8192, 64, 8192, p.w2 + ws + kp * 512, DFF, 8, t / 8, t % 8, smem);
    }
  } else if (PH == 10) {
    for (int t = bid; t < 2048; t += nb) final_tile(p, t);
  }
}

#define CEN_OFF (XCD_BAR_WORDS + 512)
#define CEN_WORDS 8704
__global__ void __launch_bounds__(256, 2) mega_kernel(Params p) {
  __shared__ __attribute__((aligned(16))) char smem[SMEM_BYTES];
  __shared__ uint4 xb_words;
  __shared__ int role_words[4];
  cg::grid_group grid = cg::this_grid();
  unsigned* cen = p.bar + CEN_OFF;
  unsigned key = 0, slot = 0;
  if (threadIdx.x == 0) {
    xb_words = make_uint4(0u, 0u, 0u, 0u);
    const unsigned hwid = (unsigned)__builtin_amdgcn_s_getreg((31 << 11) | 4);
    key = ((xb_xcc_id() & 15u) << 8) | (((hwid >> 13) & 7u) << 5) | (((hwid >> 12) & 1u) << 4) | ((hwid >> 8) & 15u);
    slot = xb_add(&cen[key], 1u);
    if (slot == 0u) { const unsigned r = xb_add(&cen[4096], 1u); __hip_atomic_store(&cen[4100 + key], r, __ATOMIC_RELAXED, __HIP_MEMORY_SCOPE_AGENT); }
  }
  __syncthreads();
  XcdBarrier xb = xcd_barrier_post(p.bar, (volatile LAS unsigned*)&xb_words);
  run_phase<0>(p, 0, smem);
  if (p.bar == nullptr) grid.sync();
  xcd_barrier(xb);
  if (threadIdx.x == 0 && xb_ld(&cen[key]) != 2u) xb_add(&cen[4097], 1u);
  int role = -1, ridx = 0;
#pragma unroll 1
  for (int layer = 0; layer < DEPTH; ++layer) {
    run_phase<1>(p, layer, smem); xcd_barrier(xb);
    if (layer == 0) {
      if (threadIdx.x == 0) {
        const unsigned bad = xb_ld(&cen[4097]), ncu = xb_ld(&cen[4096]), rank = xb_ld(&cen[4100 + key]);
        int r = -1, ri = 0;
        if (bad == 0u && gridDim.x == 512u && ncu == 256u && rank < 256u && slot < 2u) {
          if (rank < (unsigned)NSCAN) { r = (slot == 0u) ? 0 : 1; ri = (int)rank; }
          else { r = 2; ri = (int)(rank - NSCAN) * 2 + (int)slot; }
        }
        role_words[0] = r; role_words[1] = ri;
      }
      __syncthreads();
      role = role_words[0]; ridx = role_words[1];
    }
    run_phase<2>(p, layer, smem); xcd_barrier(xb);
    run_phase<3>(p, layer, smem); xcd_barrier(xb);
    run_phase<4>(p, layer, smem, role, ridx); xcd_barrier(xb);
    run_phase<5>(p, layer, smem); xcd_barrier(xb);
    run_phase<6>(p, layer, smem); xcd_barrier(xb);
    run_phase<7>(p, layer, smem); xcd_barrier(xb);
    run_phase<8>(p, layer, smem); xcd_barrier(xb);
    run_phase<9>(p, layer, smem); xcd_barrier(xb);
  }
  run_phase<10>(p, 0, smem);
}

extern "C" void kernel_launch(void* const* d_in, const int* in_sizes, int n_in, void* d_out, int out_size, void* d_ws, size_t ws_size,
                              hipStream_t stream) {
  Params p{};
  const float* const* in = (const float* const*)d_in;
  p.x = in[0]; p.c = in[1]; p.ctx = in[2]; p.c_ctx = in[3]; p.ada_w = in[4]; p.ada_b = in[5]; p.norm1_g = in[6]; p.norm2_g = in[7];
  p.w_in = in[8]; p.w_out = in[9]; p.rw_w0 = in[10]; p.rw_w2 = in[11]; p.rw_a0 = in[12]; p.rw_a2 = in[13]; p.rw_kk = in[14];
  p.rw_ka = in[15]; p.rw_rk = in[16]; p.rw_g2 = in[17]; p.rw_gnw = in[18]; p.rw_gnb = in[19]; p.na_rpb = in[20]; p.q_gain = in[21];
  p.k_gain = in[22]; p.pool_w = in[23]; p.pool_scale = in[24]; p.mlp_w1 = in[25]; p.mlp_w2 = in[26]; p.final_g = in[27];
  p.out = (float*)d_out;
  char* ws = (char*)d_ws;
  size_t off = 0;
  auto take = [&](size_t bytes) { char* r = ws + off; off += (bytes + 255) & ~(size_t)255; return r; };
  p.mod = (float*)take((size_t)DEPTH * 5 * 6144 * 4);
  p.rope = (float*)take(64 * 16 * 2 * 4);
  p.xc = (float*)take((size_t)NCTX * DM * 4);
  p.hm = (u16*)take((size_t)NTOK * DM * 2);
  p.win = (u16*)take(2 * WSET * 2);
  p.wout = p.win + (size_t)DINP * DM;
  p.w1 = p.wout + (size_t)DM * DM;
  p.w2 = p.w1 + (size_t)DFF * DM;
  p.yf = (float*)take((size_t)NTOK * 256 * 4);
  p.yb = (float*)take((size_t)NTOK * 256 * 4);
  p.qb = (u16*)take((size_t)NB * 4 * SALL * 64 * 2);
  p.kb = (u16*)take((size_t)NB * 4 * SALL * 64 * 2);
  p.vtb = (u16*)take((size_t)NB * 4 * SALL * 64 * 2);
  p.qc = (u16*)take((size_t)NB * 4 * SALL * 64 * 2);
  p.kc = (u16*)take((size_t)NB * 2 * SALL * 64 * 2);
  p.vtc = (u16*)take((size_t)NB * 2 * SALL * 64 * 2);
  char* big = ws + off;
  p.u = (u16*)big;
  p.pa = (float*)take((size_t)NTOK * PAW * 4);
  p.pb = (u16*)take((size_t)NTOK * PBW * 2);
  p.decf = (float*)take((size_t)NTOK * 256 * 4);
  p.decb = (float*)take((size_t)NTOK * 256 * 4);
  p.af = (float*)take((size_t)NTOK * 256 * 4);
  p.ab = (float*)take((size_t)NTOK * 256 * 4);
  p.kk = (float*)take((size_t)NTOK * 256 * 4);
  p.bon = (float*)take((size_t)NTOK * 4 * 4);
  p.bar = (unsigned*)take((XCD_BAR_WORDS + 512 + CEN_WORDS) * 4);
  if (off > ws_size) { fprintf(stderr, "workspace too small: need %zu have %zu\n", off, ws_size); return; }
  static int grid_blocks = 0;
  if (!grid_blocks) {
    int dev = 0, cus = 0, per_cu = 0;
    hipGetDevice(&dev);
    hipDeviceGetAttribute(&cus, hipDeviceAttributeMultiprocessorCount, dev);
    hipOccupancyMaxActiveBlocksPerMultiprocessor(&per_cu, mega_kernel, 256, 0);
    per_cu = 2;
    grid_blocks = cus * per_cu;
  }
  hipMemsetAsync(p.bar, 0, (XCD_BAR_WORDS + 512 + CEN_WORDS) * 4, stream);
  void* args[] = {&p};
  hipError_t e = hipLaunchCooperativeKernel((void*)mega_kernel, dim3(grid_blocks), dim3(256), args, 0, stream);
  if (e != hipSuccess) fprintf(stderr, "cooperative launch failed: %s (grid %d)\n", hipGetErrorString(e), grid_blocks);
}
```

```cpp
#include <hip/hip_runtime.h>
#include <hip/hip_cooperative_groups.h>
#include <cstdio>
namespace cg = cooperative_groups;

#ifndef KPL
#define KPL 4
#endif

#define DI __device__ __forceinline__
typedef unsigned short u16;
typedef short bf16x8 __attribute__((ext_vector_type(8)));
typedef float f32x16 __attribute__((ext_vector_type(16)));
typedef unsigned u32x4 __attribute__((ext_vector_type(4)));
typedef __bf16 bf16x2_t __attribute__((ext_vector_type(2)));
typedef float f32x2_t __attribute__((ext_vector_type(2)));

constexpr int NB = 4, SEQ = 4096, DM = 1024, DEPTH = 4, CTXL = 256;
constexpr int NLAT = NB * SEQ, NCTX = NB * CTXL, NTOK = NLAT + NCTX, SALL = SEQ + CTXL;
constexpr int DIN = 2496, DINP = 2560, PAW = 960, PBW = 1536, DFF = 4096;
constexpr float QSCALE = 0.125f * 1.4426950408889634f;
constexpr float LOG2E = 1.4426950408889634f;
constexpr int SMEM_BYTES = 65536;
constexpr size_t WSET = (size_t)DINP * DM + (size_t)DM * DM + 2 * (size_t)DFF * DM;

struct Params {
  const float *x, *c, *ctx, *c_ctx, *ada_w, *ada_b, *norm1_g, *norm2_g, *w_in, *w_out;
  const float *rw_w0, *rw_w2, *rw_a0, *rw_a2, *rw_kk, *rw_ka, *rw_rk, *rw_g2, *rw_gnw, *rw_gnb;
  const float *na_rpb, *q_gain, *k_gain, *pool_w, *pool_scale, *mlp_w1, *mlp_w2, *final_g;
  float *out;
  float *mod, *rope, *xc, *pa, *decf, *decb, *af, *ab, *kk, *bon, *yf, *yb;
  u16 *hm, *win, *wout, *w1, *w2, *pb, *u, *qb, *kb, *vtb, *qc, *kc, *vtc;
  unsigned* bar;
};

DI unsigned pack2(float a, float b) {
  f32x2_t v = {a, b};
  bf16x2_t r = __builtin_convertvector(v, bf16x2_t);
  return __builtin_bit_cast(unsigned, r);
}
DI float bf2f(u16 v) { return __uint_as_float(((unsigned)v) << 16); }
DI float bflo(unsigned v) { return __uint_as_float(v << 16); }
DI float bfhi(unsigned v) { return __uint_as_float(v & 0xffff0000u); }
template <int CTRL> DI float dpp_add(float x) {
  int y = __builtin_amdgcn_update_dpp(0, __builtin_bit_cast(int, x), CTRL, 0xf, 0xf, true);
  return x + __builtin_bit_cast(float, y);
}
DI float wave_sum(float v) {
  v = dpp_add<0xB1>(v);
  v = dpp_add<0x4E>(v);
  v = dpp_add<0x141>(v);
  v = dpp_add<0x140>(v);
  const int iv = __builtin_bit_cast(int, v);
  const float s0 = __builtin_bit_cast(float, __builtin_amdgcn_readlane(iv, 0));
  const float s1 = __builtin_bit_cast(float, __builtin_amdgcn_readlane(iv, 16));
  const float s2 = __builtin_bit_cast(float, __builtin_amdgcn_readlane(iv, 32));
  const float s3 = __builtin_bit_cast(float, __builtin_amdgcn_readlane(iv, 48));
  return (s0 + s1) + (s2 + s3);
}
template <class T> DI T* launder(T* q) { asm volatile("" : "+v"(q)); return q; }
DI int TID() { int t = threadIdx.x; asm volatile("" : "+v"(t)); return t; }
DI int modrow(int m) { return m < NLAT ? (m >> 12) : 4; }


#define XB_TMO      128
#define XB_XCNT(j)  (256  + 64 * (j))
#define XB_XSUB(j)  (1280 + 64 * (j))
#define XB_XGEN(j)  (2304 + 64 * (j))
#define XB_TOP      3328
#define XB_TOPGEN   3392
#define XCD_BAR_WORDS 3456
#define XB_SPIN_CAP (1u << 18)
#define LAS __attribute__((address_space(3)))
DI unsigned xb_ld(unsigned* p)              { return __hip_atomic_load(p, __ATOMIC_RELAXED, __HIP_MEMORY_SCOPE_AGENT); }
DI unsigned xb_add(unsigned* p, unsigned v) { return __hip_atomic_fetch_add(p, v, __ATOMIC_RELAXED, __HIP_MEMORY_SCOPE_AGENT); }
DI unsigned xb_xcc_id() { return (unsigned)__builtin_amdgcn_s_getreg((3 << 11) | 20) & 0xFu; }
#define XB_SPIN(cond, bar) do { unsigned _sp = 0; while (cond) { __builtin_amdgcn_s_sleep(1); \
    if ((++_sp & 255u) == 0u) { if (xb_ld(&(bar)[XB_TMO])) break; if (_sp > XB_SPIN_CAP) { atomicAdd(&(bar)[XB_TMO], 1u); break; } } } } while (0)
struct XcdBarrier { unsigned* bar; unsigned x; volatile LAS unsigned* st; };
DI XcdBarrier xcd_barrier_post(unsigned* bar, volatile LAS unsigned* st) {
  XcdBarrier b; b.bar = bar; b.x = xb_xcc_id(); b.st = st;
  if (threadIdx.x == 0) (void)xb_add(&bar[XB_XCNT(b.x)], 1u);
  return b;
}
DI void xcd_barrier_complete(unsigned* bar, unsigned x, unsigned& nloc, unsigned& nx) {
  const unsigned G = gridDim.x * gridDim.y * gridDim.z;
  unsigned sum, cnt, mine, sp = 0u;
  for (;;) {
    sum = 0u; cnt = 0u; mine = 0u;
#pragma unroll
    for (unsigned j = 0; j < 16; ++j) { const unsigned c = xb_ld(&bar[XB_XCNT(j)]); sum += c; cnt += (c > 0u) ? 1u : 0u; mine = (j == x) ? c : mine; }
    if (sum == G) break;
    __builtin_amdgcn_s_sleep(1);
    if ((++sp & 255u) == 0u) { if (xb_ld(&bar[XB_TMO])) break; if (sp > XB_SPIN_CAP) { atomicAdd(&bar[XB_TMO], 1u); break; } }
  }
  nloc = mine > 0u ? mine : 1u; nx = cnt > 0u ? cnt : 1u;
}
DI void xcd_barrier(const XcdBarrier& b) {
  asm volatile("s_waitcnt vmcnt(0)" ::: "memory");
  __syncthreads();
  if (threadIdx.x == 0) {
    unsigned* bar = b.bar;
    __builtin_amdgcn_s_waitcnt(0);
    unsigned nloc = b.st[0], nx = b.st[1];
    if (nloc == 0u) { xcd_barrier_complete(bar, b.x, nloc, nx); b.st[0] = nloc; b.st[1] = nx; }
    const unsigned old = xb_add(&bar[XB_XSUB(b.x)], 1u);
    const unsigned gen = old / nloc;
    if (old + 1u == (gen + 1u) * nloc) {
      __builtin_amdgcn_fence(__ATOMIC_RELEASE, "agent");
      asm volatile("s_waitcnt vmcnt(0)" ::: "memory");
      const unsigned og = xb_add(&bar[XB_TOP], 1u);
      const unsigned tg = og / nx;
      if (og + 1u == (tg + 1u) * nx) xb_add(&bar[XB_TOPGEN], 1u);
      else XB_SPIN(xb_ld(&bar[XB_TOPGEN]) == tg, bar);
      __builtin_amdgcn_fence(__ATOMIC_ACQUIRE, "agent");
      xb_add(&bar[XB_XGEN(b.x)], 1u);
      asm volatile("s_waitcnt vmcnt(0)" ::: "memory");
    } else {
      XB_SPIN(xb_ld(&bar[XB_XGEN(b.x)]) == gen, bar);
      __builtin_amdgcn_fence(__ATOMIC_ACQUIRE, "agent");
      asm volatile("s_waitcnt vmcnt(0)" ::: "memory");
    }
  }
  __syncthreads();
}

DI void setup_tile(const Params& p, int t, char* smem) {
  const int tid = TID();
  if (t < 384) {
    const int layer = t / 96, jt = t % 96;
    float* s = (float*)smem;
    for (int i = tid; i < 5 * 1024; i += 256) {
      int r = i >> 10, k = i & 1023;
      float v = (r < 4) ? p.c[r * 1024 + k] : p.c_ctx[k];
      s[i] = v / (1.f + expf(-v));
    }
    __syncthreads();
    const int jl = tid & 63, kg = tid >> 6;
    const int j = jt * 64 + jl;
    const float* w = p.ada_w + (size_t)layer * 1024 * 6144 + j;
    float acc[5] = {0.f, 0.f, 0.f, 0.f, 0.f};
#pragma unroll 16
    for (int k = kg * 256; k < kg * 256 + 256; k += 4) {
      const float w0 = w[(size_t)k * 6144], w1 = w[(size_t)(k + 1) * 6144], w2 = w[(size_t)(k + 2) * 6144], w3 = w[(size_t)(k + 3) * 6144];
#pragma unroll
      for (int r = 0; r < 5; ++r) {
        const float4 sv = *(const float4*)(s + r * 1024 + k);
        acc[r] += sv.x * w0 + sv.y * w1 + sv.z * w2 + sv.w * w3;
      }
    }
    float* red = s + 5 * 1024;
#pragma unroll
    for (int r = 0; r < 5; ++r) red[(kg * 5 + r) * 64 + jl] = acc[r];
    __syncthreads();
    if (tid < 64) {
#pragma unroll
      for (int r = 0; r < 5; ++r) {
        float v = red[(0 * 5 + r) * 64 + tid] + red[(1 * 5 + r) * 64 + tid] + red[(2 * 5 + r) * 64 + tid] + red[(3 * 5 + r) * 64 + tid];
        p.mod[(size_t)(layer * 5 + r) * 6144 + j] = v + p.ada_b[layer * 6144 + j];
      }
    }
    __syncthreads();
  } else {
    for (int i = tid; i < 1024; i += 256) {
      int pos = i >> 4, f = i & 15;
      float invf = exp2f(-(float)f * (13.287712379549449f / 16.f));
      float ang = (float)pos * invf;
      float kf = rintf(ang * 0.15915494309189535f);
      float r = fmaf(-kf, 6.28125f, ang);
      r = fmaf(-kf, 1.9353071795864769e-3f, r);
      p.rope[i * 2] = cosf(r);
      p.rope[i * 2 + 1] = sinf(r);
    }
  }
}

DI void convert_tile(const float* src, u16* dst, int K, int N, int kt, int nt, char* smem) {
  const int tid = TID();
  float* tile = (float*)smem;
  const int k0 = kt * 64, n0 = nt * 64;
#pragma unroll
  for (int j = 0; j < 4; ++j) {
    int kr = (tid >> 4) + 16 * j, nc = (tid & 15) * 4;
    float4 v = make_float4(0.f, 0.f, 0.f, 0.f);
    if (n0 + nc < N) v = *(const float4*)(src + (size_t)(k0 + kr) * N + n0 + nc);
    tile[kr * 65 + nc + 0] = v.x; tile[kr * 65 + nc + 1] = v.y; tile[kr * 65 + nc + 2] = v.z; tile[kr * 65 + nc + 3] = v.w;
  }
  __syncthreads();
#pragma unroll
  for (int j = 0; j < 2; ++j) {
    int n = (tid >> 3) + 32 * j, k8 = (tid & 7) * 8;
    uint4 o;
    o.x = pack2(tile[(k8 + 0) * 65 + n], tile[(k8 + 1) * 65 + n]);
    o.y = pack2(tile[(k8 + 2) * 65 + n], tile[(k8 + 3) * 65 + n]);
    o.z = pack2(tile[(k8 + 4) * 65 + n], tile[(k8 + 5) * 65 + n]);
    o.w = pack2(tile[(k8 + 6) * 65 + n], tile[(k8 + 7) * 65 + n]);
    *(uint4*)(dst + (size_t)(n0 + n) * K + k0 + k8) = o;
  }
  __syncthreads();
}

DI const float* xrow_ptr(const Params& p, int layer, int m) {
  if (layer == 0) return m < NLAT ? p.x + (size_t)m * DM : p.ctx + (size_t)(m - NLAT) * DM;
  return m < NLAT ? p.out + (size_t)m * DM : p.xc + (size_t)(m - NLAT) * DM;
}
DI float* xrow_out(const Params& p, int m) {
  return m < NLAT ? p.out + (size_t)m * DM : p.xc + (size_t)(m - NLAT) * DM;
}
DI void norm_tile(const Params& p, int layer, int which, int t) {
  const int tid_ = TID(); const int wv = tid_ >> 6, lane = tid_ & 63;
  const int m = t * 8 + wv * 2;
  const float* xa = which == 0 ? xrow_ptr(p, layer, m) : xrow_out(p, m);
  const float* xb = xa + DM;
  const float* g = (which == 0 ? p.norm1_g : p.norm2_g) + layer * DM;
  const float* shift = p.mod + (size_t)(layer * 5 + modrow(m)) * 6144 + (which ? 3 * DM : 0);
  const float* scale = shift + DM;
  float4 va[4], vb[4], g4[4], sh[4], sc[4];
#pragma unroll
  for (int j = 0; j < 4; ++j) { va[j] = ((const float4*)xa)[lane + 64 * j]; vb[j] = ((const float4*)xb)[lane + 64 * j]; }
#pragma unroll
  for (int j = 0; j < 4; ++j) { g4[j] = ((const float4*)g)[lane + 64 * j]; sh[j] = ((const float4*)shift)[lane + 64 * j]; sc[j] = ((const float4*)scale)[lane + 64 * j]; }
  float ssa = 0.f, ssb = 0.f;
#pragma unroll
  for (int j = 0; j < 4; ++j) {
    ssa += va[j].x * va[j].x + va[j].y * va[j].y + va[j].z * va[j].z + va[j].w * va[j].w;
    ssb += vb[j].x * vb[j].x + vb[j].y * vb[j].y + vb[j].z * vb[j].z + vb[j].w * vb[j].w;
  }
  ssa = wave_sum(ssa);
  ssb = wave_sum(ssb);
  const float ra = rsqrtf(ssa * (1.f / 1024.f) + 1e-6f), rb = rsqrtf(ssb * (1.f / 1024.f) + 1e-6f);
  u16* oa = p.hm + (size_t)m * DM;
#pragma unroll
  for (int j = 0; j < 4; ++j) {
    const int i4 = lane + 64 * j;
    uint2 o;
    o.x = pack2((va[j].x * ra * g4[j].x) * (1.f + sc[j].x) + sh[j].x, (va[j].y * ra * g4[j].y) * (1.f + sc[j].y) + sh[j].y);
    o.y = pack2((va[j].z * ra * g4[j].z) * (1.f + sc[j].z) + sh[j].z, (va[j].w * ra * g4[j].w) * (1.f + sc[j].w) + sh[j].w);
    ((uint2*)oa)[i4] = o;
    o.x = pack2((vb[j].x * rb * g4[j].x) * (1.f + sc[j].x) + sh[j].x, (vb[j].y * rb * g4[j].y) * (1.f + sc[j].y) + sh[j].y);
    o.y = pack2((vb[j].z * rb * g4[j].z) * (1.f + sc[j].z) + sh[j].z, (vb[j].w * rb * g4[j].w) * (1.f + sc[j].w) + sh[j].w);
    ((uint2*)(oa + DM))[i4] = o;
  }
}

template <int EPI>
DI void gemm_tile(const Params& p, int layer, const u16* __restrict__ A0, int a_rs, int a_ks, const u16* __restrict__ Bt, int K, int KT, int mt, int nt, char* smem) {
  const int tid = TID(), wv = tid >> 6, lane = tid & 63, l31 = lane & 31, h = lane >> 5;
  const int wm = wv >> 1, wn = wv & 1;
  const int m0 = mt * 128, n0 = nt * 128;
  f32x16 acc[2][2];
#pragma unroll
  for (int i = 0; i < 2; ++i)
#pragma unroll
    for (int j = 0; j < 2; ++j)
#pragma unroll
      for (int r = 0; r < 16; ++r) acc[i][j][r] = 0.f;
  const int lrow = tid >> 3, lch = tid & 7;
  const u16* ag = A0 + (size_t)lrow * a_rs + lch * 8;
  const u16* bg = Bt + (size_t)(n0 + lrow) * K + lch * 8;
  u32x4 ra0[4], rb0[4], ra1[4], rb1[4];
  char* As = smem;
  char* Bs = smem + 32768;
  auto g_load = [&](u32x4 (&RA)[4], u32x4 (&RB)[4], int kti) __attribute__((always_inline)) {
#pragma unroll
    for (int j = 0; j < 4; ++j) {
      RA[j] = *(const u32x4*)(ag + (size_t)(32 * j) * a_rs + (size_t)kti * a_ks);
      RB[j] = *(const u32x4*)(bg + (size_t)(32 * j) * K + kti * 64);
    }
  };
  auto g_store = [&](const u32x4 (&RA)[4], const u32x4 (&RB)[4], int buf) __attribute__((always_inline)) {
#pragma unroll
    for (int j = 0; j < 4; ++j) {
      int row = lrow + 32 * j;
      int off = buf * 16384 + row * 128 + ((lch ^ ((row >> 1) & 7)) << 4);
      *(u32x4*)(As + off) = RA[j];
      *(u32x4*)(Bs + off) = RB[j];
    }
  };
  auto g_frag = [&](bf16x8 (&fa)[2], bf16x8 (&fb)[2], const char* as, const char* bs, int kk) __attribute__((always_inline)) {
    const int chunk = kk * 2 + h;
#pragma unroll
    for (int i = 0; i < 2; ++i) {
      int row = wm * 64 + i * 32 + l31;
      fa[i] = *(const bf16x8*)(as + row * 128 + ((chunk ^ ((row >> 1) & 7)) << 4));
      int rowb = wn * 64 + i * 32 + l31;
      fb[i] = *(const bf16x8*)(bs + rowb * 128 + ((chunk ^ ((rowb >> 1) & 7)) << 4));
    }
  };
  auto g_mma = [&](const bf16x8 (&fa)[2], const bf16x8 (&fb)[2]) __attribute__((always_inline)) {
#pragma unroll
    for (int i = 0; i < 2; ++i)
#pragma unroll
      for (int j = 0; j < 2; ++j) acc[i][j] = __builtin_amdgcn_mfma_f32_32x32x16_bf16(fa[i], fb[j], acc[i][j], 0, 0, 0);
  };
  auto g_compute = [&](int buf) __attribute__((always_inline)) {
    const char* as = As + buf * 16384;
    const char* bs = Bs + buf * 16384;
    bf16x8 fa0[2], fb0[2], fa1[2], fb1[2];
    g_frag(fa0, fb0, as, bs, 0);
    g_frag(fa1, fb1, as, bs, 1);
    __builtin_amdgcn_sched_barrier(0);
    g_mma(fa0, fb0);
    __builtin_amdgcn_sched_barrier(0);
    g_frag(fa0, fb0, as, bs, 2);
    __builtin_amdgcn_sched_barrier(0);
    g_mma(fa1, fb1);
    __builtin_amdgcn_sched_barrier(0);
    g_frag(fa1, fb1, as, bs, 3);
    __builtin_amdgcn_sched_barrier(0);
    g_mma(fa0, fb0);
    g_mma(fa1, fb1);
  };
  g_load(ra0, rb0, 0);
  g_load(ra1, rb1, 1);
  g_store(ra0, rb0, 0);
  __syncthreads();
  g_load(ra0, rb0, 2);
  for (int kt = 0; kt < KT; kt += 2) {
    g_compute(0);
    g_store(ra1, rb1, 1);
    __syncthreads();
    if (kt + 3 < KT) g_load(ra1, rb1, kt + 3);
    g_compute(1);
    if (kt + 2 < KT) g_store(ra0, rb0, 0);
    __syncthreads();
    if (kt + 4 < KT) g_load(ra0, rb0, kt + 4);
  }
  if (EPI == 1 || EPI == 3 || EPI == 5) {
    const float* gbase = p.mod + (size_t)(layer * 5 + modrow(m0)) * 6144 + ((EPI == 1) ? 2 : 5) * DM;
    float* xb = xrow_out(p, m0 + wm * 64 + 4 * h);
    const float* xi = (EPI == 1) ? xrow_ptr(p, layer, m0 + wm * 64 + 4 * h) : xb;
#pragma unroll
    for (int j = 0; j < 2; ++j) {
      const int col = n0 + wn * 64 + j * 32 + l31;
      const float gate = gbase[col] * ((EPI == 5) ? 0.0f : 1.0f);
      float xv[2][16];
#pragma unroll
      for (int i = 0; i < 2; ++i)
#pragma unroll
        for (int r = 0; r < 16; ++r) xv[i][r] = xi[(size_t)(i * 32 + (r & 3) + 8 * (r >> 2)) * DM + col];
#pragma unroll
      for (int i = 0; i < 2; ++i)
#pragma unroll
        for (int r = 0; r < 16; ++r) xb[(size_t)(i * 32 + (r & 3) + 8 * (r >> 2)) * DM + col] = xv[i][r] + gate * acc[i][j][r];
    }
    return;
  }
#pragma unroll
  for (int i = 0; i < 2; ++i) {
#pragma unroll
    for (int j = 0; j < 2; ++j) {
      const int col = n0 + wn * 64 + j * 32 + l31;
#pragma unroll
      for (int r = 0; r < 16; ++r) {
        const int row = m0 + wm * 64 + i * 32 + (r & 3) + 8 * (r >> 2) + 4 * h;
        const float v = acc[i][j][r];
        if (EPI == 0) {
          if (col < PAW) p.pa[(size_t)row * PAW + col] = v;
          else if (col < DIN) p.pb[(size_t)row * PBW + (col - PAW)] = (u16)(pack2(v, 0.f) & 0xffff);
        } else if (EPI == 4) {
          float* xo = xrow_out(p, row);
          const float gate = p.mod[(size_t)(layer * 5 + modrow(row)) * 6144 + 5 * DM + col];
          atomicAdd(xo + col, gate * v);
        } else {
          float rl = fmaxf(v, 0.f);
          p.u[((size_t)((row >> 7) * 64 + (col >> 6)) * 128 + (row & 127)) * 64 + (col & 63)] = (u16)(pack2(rl * rl, 0.f) & 0xffff);
        }
      }
    }
  }
}

DI float fsigmoid(float x) { return __builtin_amdgcn_rcpf(1.f + __builtin_amdgcn_exp2f(-x * LOG2E)); }
constexpr int PTOK = 34;
DI void rwkv_prep_tile(const Params& p, int layer, int t, char* smem) {
  const int tid = TID(), lane = tid & 63, wv = tid >> 6;
  const int m0 = t * PTOK, j = tid;
  float* lo = (float*)smem;
  for (int i = tid; i < PTOK * 128; i += 256) {
    int tok = i >> 7, cc = i & 127;
    float v = p.pa[(size_t)(m0 + tok) * PAW + 768 + cc];
    if (cc < 64) v = 2.f * fsigmoid(2.f * v) - 1.f;
    lo[i] = v;
  }
  const float kkc = p.rw_kk[layer * 256 + j], kac = p.rw_ka[layer * 256 + j], rkc = p.rw_rk[layer * 256 + j];
  __syncthreads();
  {
    float wf[32], wb[32];
    const float* wq = launder(p.rw_w2 + (size_t)(layer * 2 * 32) * 256 + j);
#pragma unroll
    for (int k = 0; k < 32; ++k) {
      wf[k] = wq[k * 256];
      wb[k] = wq[(32 + k) * 256];
    }
    const float w0f = p.rw_w0[(layer * 2 + 0) * 256 + j], w0b = p.rw_w0[(layer * 2 + 1) * 256 + j];
#pragma unroll 1
    for (int tok = 0; tok < PTOK; ++tok) {
      float d0 = w0f, d1 = w0b;
      const float4* l4 = (const float4*)(lo + tok * 128);
#pragma unroll
      for (int k4 = 0; k4 < 8; ++k4) {
        float4 x0 = l4[k4], x1 = l4[8 + k4];
        d0 += x0.x * wf[4 * k4] + x0.y * wf[4 * k4 + 1] + x0.z * wf[4 * k4 + 2] + x0.w * wf[4 * k4 + 3];
        d1 += x1.x * wb[4 * k4] + x1.y * wb[4 * k4 + 1] + x1.z * wb[4 * k4 + 2] + x1.w * wb[4 * k4 + 3];
      }
      const size_t m = (size_t)(m0 + tok);
      p.decf[m * 256 + j] = __builtin_amdgcn_exp2f(-0.60653066f * LOG2E * fsigmoid(d0));
      p.decb[m * 256 + j] = __builtin_amdgcn_exp2f(-0.60653066f * LOG2E * fsigmoid(d1));
    }
  }
  {
    float a_f[32], a_b[32];
    const float* aq = launder(p.rw_a2 + (size_t)(layer * 2 * 32) * 256 + j);
#pragma unroll
    for (int k = 0; k < 32; ++k) {
      a_f[k] = aq[k * 256];
      a_b[k] = aq[(32 + k) * 256];
    }
    const float a0f = p.rw_a0[(layer * 2 + 0) * 256 + j], a0b = p.rw_a0[(layer * 2 + 1) * 256 + j];
#pragma unroll 1
    for (int tok = 0; tok < PTOK; ++tok) {
      float d2 = a0f, d3 = a0b;
      const float4* l4 = (const float4*)(lo + tok * 128);
#pragma unroll
      for (int k4 = 0; k4 < 8; ++k4) {
        float4 x2 = l4[16 + k4], x3 = l4[24 + k4];
        d2 += x2.x * a_f[4 * k4] + x2.y * a_f[4 * k4 + 1] + x2.z * a_f[4 * k4 + 2] + x2.w * a_f[4 * k4 + 3];
        d3 += x3.x * a_b[4 * k4] + x3.y * a_b[4 * k4 + 1] + x3.z * a_b[4 * k4 + 2] + x3.w * a_b[4 * k4 + 3];
      }
      const float af = fsigmoid(d2);
      const float ab = fsigmoid(d3);
      const size_t m = (size_t)(m0 + tok);
      const float r = p.pa[m * PAW + j], k = p.pa[m * PAW + 256 + j];
      const float kr = k * kkc;
      const float ss = wave_sum(kr * kr);
      const float kkn = kr * rsqrtf(fmaxf(ss, 1e-24f));
      const float kmf = k * (1.f + (af - 1.f) * kac), kmb = k * (1.f + (ab - 1.f) * kac);
      const float bs = wave_sum(r * (kmf + kmb) * rkc);
      p.af[m * 256 + j] = af; p.ab[m * 256 + j] = ab; p.kk[m * 256 + j] = kkn;
      if (lane == 0) p.bon[m * 4 + wv] = bs;
    }
  }
  __syncthreads();
}

DI void attn_prep_tile(const Params& p, int layer, int t, char* smem) {
  const int tid = TID();
  const int m0 = t * 64;
  int b, pos0, islat, grow;
  if (m0 < NLAT) { b = m0 >> 12; int tl = m0 & 4095; pos0 = CTXL + tl; islat = 1; grow = tl >> 6; }
  else { b = (m0 - NLAT) >> 8; pos0 = (m0 - NLAT) & 255; islat = 0; grow = 0; }
  const int tok = tid >> 2, c = tid & 3;
  const size_t m = (size_t)(m0 + tok);
  u16* T = (u16*)smem;
#pragma unroll 1
  for (int s = 0; s < 20; ++s) {
    const u16* src = p.pb + m * PBW + s * 64 + c * 16;
    uint4 r0 = *(const uint4*)src, r1 = *(const uint4*)(src + 8);
    float x[16];
    x[0] = bflo(r0.x); x[1] = bfhi(r0.x); x[2] = bflo(r0.y); x[3] = bfhi(r0.y);
    x[4] = bflo(r0.z); x[5] = bfhi(r0.z); x[6] = bflo(r0.w); x[7] = bfhi(r0.w);
    x[8] = bflo(r1.x); x[9] = bfhi(r1.x); x[10] = bflo(r1.y); x[11] = bfhi(r1.y);
    x[12] = bflo(r1.z); x[13] = bfhi(r1.z); x[14] = bflo(r1.w); x[15] = bfhi(r1.w);
    const bool isv = (s >= 8 && s < 12) || s >= 18;
    if (!isv) {
      u16* dst;
      float scl = 1.f;
      if (s < 4) { dst = p.qb + ((size_t)(b * 4 + s) * SALL + pos0 + tok) * 64; scl = QSCALE; }
      else if (s < 8) { dst = p.kb + ((size_t)(b * 4 + (s - 4)) * SALL + pos0 + tok) * 64; }
      else if (s < 16) { dst = p.qc + ((size_t)(b * 4 + (s - 12)) * SALL + pos0 + tok) * 64; scl = QSCALE; }
      else { dst = p.kc + ((size_t)(b * 2 + (s - 16)) * SALL + pos0 + tok) * 64; }
      if (s >= 12) {
        float ss = 0.f;
#pragma unroll
        for (int i = 0; i < 16; ++i) ss += x[i] * x[i];
        ss = dpp_add<0xB1>(ss);
        ss = dpp_add<0x4E>(ss);
        const float rstd = rsqrtf(ss * (1.f / 64.f) + 1e-6f);
        const float* gn = (s < 16 ? p.q_gain : p.k_gain) + layer * 64 + c * 16;
#pragma unroll
        for (int i = 0; i < 16; ++i) x[i] = x[i] * rstd * gn[i];
        if (islat) {
          const int posv = (c & 1) ? tok : grow;
          const float sgn = (c < 2) ? -1.f : 1.f;
          const float* rt = p.rope + (size_t)posv * 32;
#pragma unroll
          for (int i = 0; i < 16; ++i) {
            float part = __builtin_bit_cast(float, __builtin_amdgcn_update_dpp(0, __builtin_bit_cast(int, x[i]), 0x4E, 0xf, 0xf, true));
            float cs = rt[2 * i], sn = rt[2 * i + 1];
            x[i] = x[i] * cs + sgn * part * sn;
          }
        }
      }
      uint4 o0, o1;
      o0.x = pack2(x[0] * scl, x[1] * scl); o0.y = pack2(x[2] * scl, x[3] * scl);
      o0.z = pack2(x[4] * scl, x[5] * scl); o0.w = pack2(x[6] * scl, x[7] * scl);
      o1.x = pack2(x[8] * scl, x[9] * scl); o1.y = pack2(x[10] * scl, x[11] * scl);
      o1.z = pack2(x[12] * scl, x[13] * scl); o1.w = pack2(x[14] * scl, x[15] * scl);
      *(uint4*)(dst + c * 16) = o0;
      *(uint4*)(dst + c * 16 + 8) = o1;
    } else {
      const unsigned wd[8] = {r0.x, r0.y, r0.z, r0.w, r1.x, r1.y, r1.z, r1.w};
#pragma unroll
      for (int i = 0; i < 8; ++i) {
        T[(c * 16 + 2 * i) * 72 + tok] = (u16)(wd[i] & 0xffffu);
        T[(c * 16 + 2 * i + 1) * 72 + tok] = (u16)(wd[i] >> 16);
      }
      __syncthreads();
      const int d = tid >> 2, ch = tid & 3;
      uint4 v0 = *(const uint4*)(T + d * 72 + ch * 16), v1 = *(const uint4*)(T + d * 72 + ch * 16 + 8);
      u16* dst = (s < 12) ? p.vtb + ((size_t)(b * 4 + (s - 8)) * 64 + d) * SALL + pos0 + ch * 16
                          : p.vtc + ((size_t)(b * 2 + (s - 18)) * 64 + d) * SALL + pos0 + ch * 16;
      *(uint4*)dst = v0;
      *(uint4*)(dst + 8) = v1;
      __syncthreads();
    }
  }
}

DI void pool_tile(const Params& p, int layer, int t, char* smem) {
  const int tid = TID(), lane = tid & 63, g = tid >> 6;
  const int m0 = t * 64;
  int tl, n, mbase;
  if (m0 < NLAT) { tl = m0 & 4095; n = SEQ; mbase = m0 - tl; }
  else { tl = (m0 - NLAT) & 255; n = CTXL; mbase = m0 - tl; }
  u16* sp = (u16*)smem;
  float* sdiff = (float*)(smem + 40960);
  for (int i = tid; i < 80 * 32; i += 256) {
    int row = i >> 5, c8 = i & 31;
    int tt = tl - 8 + row;
    if (tt >= 0 && tt < n) *(uint4*)(sp + row * 256 + c8 * 8) = *(const uint4*)(p.pb + (size_t)(mbase + tt) * PBW + 1280 + c8 * 8);
  }
  float wreg[64];
  const float* wp0 = launder(p.pool_w + (size_t)((layer * 4 + g) * 64) * 64 + lane);
#pragma unroll
  for (int cc = 0; cc < 64; ++cc) wreg[cc] = wp0[cc * 64];
  const float psc = p.pool_scale[layer * 256 + tid];
  const int w = 2 << g;
  __syncthreads();
#pragma unroll 1
  for (int sub = 0; sub < 4; ++sub) {
#pragma unroll 1
    for (int tt = 0; tt < 16; ++tt) {
      int tq = tl + sub * 16 + tt;
      int lo = max(tq - w / 2, 0), hi = min(tq - w / 2 + w, n);
      float sum = 0.f;
      for (int u = lo; u < hi; ++u) sum += bf2f(sp[(u - tl + 8) * 256 + tid]);
      float self = bf2f(sp[(tq - tl + 8) * 256 + tid]);
      sdiff[tt * 256 + tid] = sum / (float)(hi - lo) - self;
    }
    __syncthreads();
#pragma unroll 1
    for (int tt = 0; tt < 16; ++tt) {
      const float4* d4 = (const float4*)(sdiff + tt * 256 + g * 64);
      float acc = 0.f;
#pragma unroll
      for (int c4 = 0; c4 < 16; ++c4) {
        float4 dv = d4[c4];
        acc += dv.x * wreg[4 * c4] + dv.y * wreg[4 * c4 + 1] + dv.z * wreg[4 * c4 + 2] + dv.w * wreg[4 * c4 + 3];
      }
      p.hm[(size_t)(m0 + sub * 16 + tt) * DM + 768 + tid] = (u16)(pack2(acc * psc, 0.f) & 0xffff);
    }
    __syncthreads();
  }
}

template <int LPRv> DI float row_reduce(float x) {
  x = dpp_add<0xB1>(x);
  x = dpp_add<0x4E>(x);
  if (LPRv >= 8) x = dpp_add<0x141>(x);
  if (LPRv >= 16) x = dpp_add<0x140>(x);
  return x;
}
DI int scan_tok(int b, int dir, int c, int i) {
  if (c < 16) { int s = c * 16 + i; return NLAT + b * CTXL + (dir ? (CTXL - 1 - s) : s); }
  int s = (c - 16) * 16 + i;
  return b * SEQ + (dir ? (SEQ - 1 - s) : s);
}
typedef float v4f __attribute__((ext_vector_type(4)));
typedef float v2f __attribute__((ext_vector_type(2)));
#define SCAN_LD(nw, nk, nb, nm, nr, nv, aaddr, vaddr, SA, SB) asm volatile( \
    "ds_read_b128 %0, %8\n\tds_read_b128 %1, %8 offset:4096\n\tds_read_b128 %2, %8 offset:8192\n\tds_read_b128 %3, %8 offset:12288\n\tds_read_b128 %4, %8 offset:16384\n\tds_read_b32 %5, %9" \
    : "=&v"(nw), "=&v"(nk), "=&v"(nb), "=&v"(nm), "=&v"(nr), "=&v"(nv), "+v"(SA), "+v"(SB) : "v"(aaddr), "v"(vaddr))
#define SCAN_LDI(nw, nk, nb, nm, nr, nv, aaddr, vaddr, SA, SB, OFF) asm volatile( \
    "ds_read_b128 %0, %8 offset:%10\n\tds_read_b128 %1, %8 offset:%11\n\tds_read_b128 %2, %8 offset:%12\n\tds_read_b128 %3, %8 offset:%13\n\tds_read_b128 %4, %8 offset:%14\n\tds_read_b32 %5, %9 offset:%10" \
    : "=&v"(nw), "=&v"(nk), "=&v"(nb), "=&v"(nm), "=&v"(nr), "=&v"(nv), "+v"(SA), "+v"(SB) : "v"(aaddr), "v"(vaddr), \
      "n"(OFF), "n"((OFF) + 4096), "n"((OFF) + 8192), "n"((OFF) + 12288), "n"((OFF) + 16384))
#define SCAN_WAIT(nw, nk, nb, nm, nr, nv, SA, SB) asm volatile("s_waitcnt lgkmcnt(0)" : "+v"(nw), "+v"(nk), "+v"(nb), "+v"(nm), "+v"(nr), "+v"(nv), "+v"(SA), "+v"(SB))
#define SCAN_WAIT6(nw, nk, nb, nm, nr, nv, SA, SB) asm volatile("s_waitcnt lgkmcnt(6)" : "+v"(nw), "+v"(nk), "+v"(nb), "+v"(nm), "+v"(nr), "+v"(nv), "+v"(SA), "+v"(SB))
template <int CTRL> DI float dpp_mov(float x) {
  return __builtin_bit_cast(float, __builtin_amdgcn_update_dpp(0, __builtin_bit_cast(int, x), CTRL, 0xf, 0xf, true));
}
DI void scan_item(const Params& p, int layer, int sb, char* smem) {
  constexpr int LPR = 64 / KPL, RPB = 4 * KPL, BPI = 16 / KPL, YPL = 16 / LPR;
  const int tid = TID(), wv = tid >> 6, lane = tid & 63;
  const int item = sb / BPI, part = sb % BPI;
  const int b = item >> 3, hh = (item >> 1) & 3, dir = item & 1;
  const int row = part * RPB + wv * KPL + lane / LPR, kq = lane % LPR;
  const float* dec = dir ? p.decb : p.decf;
  const float* aa = dir ? p.ab : p.af;
  float* Y = dir ? p.yb : p.yf;
  const int li = tid >> 4, lf = tid & 15;
  const float4 ka4 = *(const float4*)(p.rw_ka + layer * 256 + hh * 64 + lf * 4);
  v2f SA = {0.f, 0.f}, SB = {0.f, 0.f};
  const bool c3 = (kq & 8) != 0, c2 = (kq & 4) != 0, c1 = (kq & 2) != 0, c0 = (kq & 1) != 0;
  const int sidx = (c3 ? 8 : 0) + (c2 ? 4 : 0) + (c0 ? 2 : 0) + (c1 ? 1 : 0);
  float* bufs = (float*)smem;
  const unsigned lds0 = (unsigned)(size_t)smem;
  float4 gr, gk, gv, gd, ga, gkk;
  auto gload = [&](int c) {
    size_t m = (size_t)scan_tok(b, dir, c, li);
    const float* pr = p.pa + m * PAW + hh * 64 + lf * 4;
    gr = *(const float4*)pr; gk = *(const float4*)(pr + 256); gv = *(const float4*)(pr + 512);
    size_t o = m * 256 + hh * 64 + lf * 4;
    gd = *(const float4*)(dec + o); ga = *(const float4*)(aa + o); gkk = *(const float4*)(p.kk + o);
  };
  auto lstore = [&](int bi) {
    float* bb = bufs + bi * 6144 + li * 64 + lf * 4;
    *(float4*)(bb) = gd;
    *(float4*)(bb + 1024) = gkk;
    *(float4*)(bb + 2048) = make_float4(gkk.x * ga.x, gkk.y * ga.y, gkk.z * ga.z, gkk.w * ga.w);
    *(float4*)(bb + 3072) = make_float4(gk.x * (1.f + (ga.x - 1.f) * ka4.x), gk.y * (1.f + (ga.y - 1.f) * ka4.y),
                                        gk.z * (1.f + (ga.z - 1.f) * ka4.z), gk.w * (1.f + (ga.w - 1.f) * ka4.w));
    *(float4*)(bb + 4096) = gr;
    *(float4*)(bb + 5120) = gv;
  };
  __builtin_amdgcn_s_setprio(3);
  gload(0);
  lstore(0);
  __syncthreads();
  for (int c = 0; c < 272; ++c) {
    if (c + 1 < 272) gload(c + 1);
    float yp[16];
    v4f qw[3], qk[3], qb[3], qm[3], qr[3];
    float qv[3];
    const unsigned abase = lds0 + (unsigned)(c & 1) * 24576u + (unsigned)kq * 16u;
    const unsigned vbase = lds0 + (unsigned)(c & 1) * 24576u + 20480u + (unsigned)row * 4u;
    SCAN_LDI(qw[0], qk[0], qb[0], qm[0], qr[0], qv[0], abase, vbase, SA, SB, 0);
    SCAN_LDI(qw[1], qk[1], qb[1], qm[1], qr[1], qv[1], abase, vbase, SA, SB, 256);
    SCAN_WAIT6(qw[0], qk[0], qb[0], qm[0], qr[0], qv[0], SA, SB);
#define SCAN_STEP(I) { \
      constexpr int cs = (I) % 3, ns = ((I) + 1) % 3, fs = ((I) + 2) % 3; \
      const v2f w0 = {qw[cs][0], qw[cs][1]}, w1 = {qw[cs][2], qw[cs][3]}, k0 = {qk[cs][0], qk[cs][1]}, k1 = {qk[cs][2], qk[cs][3]}; \
      const v2f b0 = {qb[cs][0], qb[cs][1]}, b1 = {qb[cs][2], qb[cs][3]}, m0 = {qm[cs][0], qm[cs][1]}, m1 = {qm[cs][2], qm[cs][3]}; \
      const v2f r0 = {qr[cs][0], qr[cs][1]}, r1 = {qr[cs][2], qr[cs][3]}; \
      const float vv = qv[cs]; \
      if ((I) + 2 < 16) { SCAN_LDI(qw[fs], qk[fs], qb[fs], qm[fs], qr[fs], qv[fs], abase, vbase, SA, SB, (((I) + 2) & 15) * 256); } \
      v2f t = SA * k0; \
      t = __builtin_elementwise_fma(SB, k1, t); \
      const float sa = row_reduce<LPR>(t[0] + t[1]); \
      const v2f nsa = {-sa, -sa}, vv2 = {vv, vv}; \
      SA = __builtin_elementwise_fma(vv2, m0, __builtin_elementwise_fma(nsa, b0, SA * w0)); \
      SB = __builtin_elementwise_fma(vv2, m1, __builtin_elementwise_fma(nsa, b1, SB * w1)); \
      v2f u = SA * r0; \
      u = __builtin_elementwise_fma(SB, r1, u); \
      yp[I] = u[0] + u[1]; \
      if ((I) + 1 < 16) { \
        if ((I) + 2 < 16) { SCAN_WAIT6(qw[ns], qk[ns], qb[ns], qm[ns], qr[ns], qv[ns], SA, SB); } \
        else { SCAN_WAIT(qw[ns], qk[ns], qb[ns], qm[ns], qr[ns], qv[ns], SA, SB); } \
      } }
    SCAN_STEP(0) SCAN_STEP(1) SCAN_STEP(2) SCAN_STEP(3) SCAN_STEP(4) SCAN_STEP(5) SCAN_STEP(6) SCAN_STEP(7)
    SCAN_STEP(8) SCAN_STEP(9) SCAN_STEP(10) SCAN_STEP(11) SCAN_STEP(12) SCAN_STEP(13) SCAN_STEP(14) SCAN_STEP(15)
#undef SCAN_STEP
    float yfin;
    {
      float q[8], r4[4], r2[2];
#pragma unroll
      for (int m = 0; m < 8; ++m) { float mine = c3 ? yp[m + 8] : yp[m]; float oth = c3 ? yp[m] : yp[m + 8]; q[m] = mine + dpp_mov<0x128>(oth); }
#pragma unroll
      for (int m = 0; m < 4; ++m) { float mine = c2 ? q[m + 4] : q[m]; float oth = c2 ? q[m] : q[m + 4]; r4[m] = mine + dpp_mov<0x141>(oth); }
#pragma unroll
      for (int m = 0; m < 2; ++m) { float mine = c0 ? r4[m + 2] : r4[m]; float oth = c0 ? r4[m] : r4[m + 2]; r2[m] = mine + dpp_mov<0xB1>(oth); }
      float mine = c1 ? r2[1] : r2[0]; float oth = c1 ? r2[0] : r2[1];
      yfin = mine + dpp_mov<0x4E>(oth);
    }
    {
      size_t m = (size_t)scan_tok(b, dir, c, sidx);
      Y[m * 256 + hh * 64 + row] = yfin;
    }
    if (c + 1 < 272) lstore((c + 1) & 1);
    __syncthreads();
  }
  __builtin_amdgcn_s_setprio(0);
}

template <int NA>
DI void attn_item(const Params& p, const u16* __restrict__ Qb, const u16* __restrict__ Kb, const u16* __restrict__ Vtb, int ntiles,
                  int mrow0, int colbase, int rp, const float* rpbh, char* smem) {
  const int tid = TID(), wv = tid >> 6, lane = tid & 63, l31 = lane & 31, h = lane >> 5;
  char* Kbuf = smem;
  char* Vbuf = smem + 16384;
  float* rpbL = (float*)(smem + 16384 + 17408);
  int rs0 = 0, nloc = 0, qr = 0, myrs = 0;
  if (NA) {
    int r0 = rp * 2, r1 = r0 + 1;
    rs0 = min(max(r0 - 4, 0), 56);
    int rs1 = min(max(r1 - 4, 0), 56);
    nloc = rs1 + 8 - rs0;
    qr = r0 + (wv >> 1);
    myrs = min(max(qr - 4, 0), 56);
    for (int i = tid; i < 465; i += 256) rpbL[i] = rpbh[i] * LOG2E;
  }
  bf16x8 qf[4];
  {
    const u16* qp = Qb + (size_t)(wv * 32 + l31) * 64 + 8 * h;
#pragma unroll
    for (int kk = 0; kk < 4; ++kk) qf[kk] = *(const bf16x8*)(qp + kk * 16);
  }
  f32x16 o[2];
#pragma unroll
  for (int dt = 0; dt < 2; ++dt)
#pragma unroll
    for (int r = 0; r < 16; ++r) o[dt][r] = 0.f;
  float mrun = -INFINITY, lsum = 0.f;
  const int lr = tid >> 2, lc = tid & 3;
  struct TileRegs { u32x4 k0, k1, v0, v1; };
  TileRegs ta, tb;
  auto tilepos = [&](int j) -> int {
    if (NA) return j < nloc ? CTXL + (rs0 + j) * 64 : (j - nloc) * 64;
    return j * 64;
  };
  auto gload = [&](TileRegs& tr, int j) __attribute__((always_inline)) {
    int pos0 = tilepos(j);
    const u16* ks = Kb + (size_t)(pos0 + lr) * 64 + lc * 16;
    tr.k0 = *(const u32x4*)ks; tr.k1 = *(const u32x4*)(ks + 8);
    const u16* vs = Vtb + (size_t)lr * SALL + pos0 + lc * 16;
    tr.v0 = *(const u32x4*)vs; tr.v1 = *(const u32x4*)(vs + 8);
  };
  auto lstore = [&](const TileRegs& tr, int bi) __attribute__((always_inline)) {
    char* kb = Kbuf + bi * 8192 + lr * 128;
    int sw = (lr >> 1) & 7;
    *(u32x4*)(kb + (((lc * 2) ^ sw) << 4)) = tr.k0;
    *(u32x4*)(kb + (((lc * 2 + 1) ^ sw) << 4)) = tr.k1;
    char* vb = Vbuf + bi * 8704 + lr * 136 + lc * 32;
    *(uint2*)(vb) = make_uint2(tr.v0[0], tr.v0[1]);
    *(uint2*)(vb + 8) = make_uint2(tr.v0[2], tr.v0[3]);
    *(uint2*)(vb + 16) = make_uint2(tr.v1[0], tr.v1[1]);
    *(uint2*)(vb + 24) = make_uint2(tr.v1[2], tr.v1[3]);
  };
  auto compute = [&](int j, int bi) __attribute__((always_inline)) {
    bool skip = false;
    int krow = 0;
    bool local = false;
    if (NA && j < nloc) { local = true; krow = rs0 + j; skip = (krow < myrs) || (krow >= myrs + 8); }
    if (!skip) {
      const char* kb = Kbuf + bi * 8192;
      const char* vb = Vbuf + bi * 8704;
      f32x16 s[2];
#pragma unroll
      for (int sub = 0; sub < 2; ++sub) {
#pragma unroll
        for (int r = 0; r < 16; ++r) s[sub][r] = 0.f;
        const int row = sub * 32 + l31;
#pragma unroll
        for (int kk = 0; kk < 4; ++kk) {
          bf16x8 a = *(const bf16x8*)(kb + row * 128 + (((kk * 2 + h) ^ ((row >> 1) & 7)) << 4));
          s[sub] = __builtin_amdgcn_mfma_f32_32x32x16_bf16(a, qf[kk], s[sub], 0, 0, 0);
        }
      }
      if (NA && local) {
        const int qc = (wv & 1) * 32 + l31;
        const int cs = min(max(qc - 8, 0), 48);
        const float* brow = rpbL + (krow - qr + 7) * 31 + 15 - qc;
#pragma unroll
        for (int sub = 0; sub < 2; ++sub)
#pragma unroll
          for (int r = 0; r < 16; ++r) {
            int kc = sub * 32 + (r & 3) + 8 * (r >> 2) + 4 * h;
            bool valid = (kc >= cs) && (kc < cs + 16);
            float bias = valid ? brow[kc] : 0.f;
            s[sub][r] = valid ? s[sub][r] + bias : -INFINITY;
          }
      }
      float mx = s[0][0];
#pragma unroll
      for (int r = 1; r < 16; ++r) mx = fmaxf(mx, s[0][r]);
#pragma unroll
      for (int r = 0; r < 16; ++r) mx = fmaxf(mx, s[1][r]);
      mx = fmaxf(mx, __shfl_xor(mx, 32));
      const float mnew = fmaxf(mrun, mx);
      const float alpha = __builtin_amdgcn_exp2f(mrun - mnew);
      mrun = mnew;
      float ps = 0.f;
#pragma unroll
      for (int sub = 0; sub < 2; ++sub)
#pragma unroll
        for (int r = 0; r < 16; ++r) { float e = __builtin_amdgcn_exp2f(s[sub][r] - mnew); s[sub][r] = e; ps += e; }
      lsum = lsum * alpha + ps;
#pragma unroll
      for (int dt = 0; dt < 2; ++dt)
#pragma unroll
        for (int r = 0; r < 16; ++r) o[dt][r] *= alpha;
#pragma unroll
      for (int sub = 0; sub < 2; ++sub) {
#pragma unroll
        for (int s16 = 0; s16 < 2; ++s16) {
          unsigned pk[4];
#pragma unroll
          for (int e = 0; e < 4; ++e) pk[e] = pack2(s[sub][8 * s16 + 2 * e], s[sub][8 * s16 + 2 * e + 1]);
          bf16x8 pb = __builtin_bit_cast(bf16x8, *(uint4*)pk);
#pragma unroll
          for (int dt = 0; dt < 2; ++dt) {
            const char* va = vb + (32 * dt + l31) * 136 + (32 * sub + 16 * s16 + 4 * h) * 2;
            uint2 v0 = *(const uint2*)va, v1 = *(const uint2*)(va + 16);
            uint4 vv = make_uint4(v0.x, v0.y, v1.x, v1.y);
            bf16x8 a = __builtin_bit_cast(bf16x8, vv);
            o[dt] = __builtin_amdgcn_mfma_f32_32x32x16_bf16(a, pb, o[dt], 0, 0, 0);
          }
        }
      }
    }
  };
  gload(ta, 0);
  if (ntiles > 1) gload(tb, 1);
  lstore(ta, 0);
  __syncthreads();
  if (ntiles > 2) gload(ta, 2);
#pragma unroll 1
  for (int j = 0; j < ntiles; j += 2) {
    compute(j, 0);
    if (j + 1 < ntiles) lstore(tb, 1);
    __syncthreads();
    if (j + 3 < ntiles) gload(tb, j + 3);
    if (j + 1 < ntiles) compute(j + 1, 1);
    if (j + 2 < ntiles) lstore(ta, 0);
    __syncthreads();
    if (j + 4 < ntiles) gload(ta, j + 4);
  }
  const float ltot = lsum + __shfl_xor(lsum, 32);
  const float inv = 1.f / ltot;
  u16* orow = p.hm + (size_t)(mrow0 + wv * 32 + l31) * DM + colbase;
#pragma unroll
  for (int dt = 0; dt < 2; ++dt)
#pragma unroll
    for (int i4 = 0; i4 < 4; ++i4) {
      int d0 = 32 * dt + 8 * i4 + 4 * h;
      uint2 ov;
      ov.x = pack2(o[dt][4 * i4] * inv, o[dt][4 * i4 + 1] * inv);
      ov.y = pack2(o[dt][4 * i4 + 2] * inv, o[dt][4 * i4 + 3] * inv);
      *(uint2*)(orow + d0) = ov;
    }
}

DI void attn_dispatch(const Params& p, int layer, int it, char* smem) {
  if (it < 512) {
    int b = it >> 7, hd = (it >> 5) & 3, qt = it & 31;
    const u16* Q = p.qc + ((size_t)(b * 4 + hd) * SALL + CTXL + qt * 128) * 64;
    const u16* K = p.kc + (size_t)(b * 2 + (hd >> 1)) * SALL * 64;
    const u16* V = p.vtc + (size_t)(b * 2 + (hd >> 1)) * 64 * SALL;
    attn_item<0>(p, Q, K, V, 68, b * SEQ + qt * 128, 512 + hd * 64, 0, nullptr, smem);
  } else if (it < 1024) {
    int i2 = it - 512;
    int b = i2 >> 7, hd = (i2 >> 5) & 3, rp = i2 & 31;
    const u16* Q = p.qb + ((size_t)(b * 4 + hd) * SALL + CTXL + rp * 128) * 64;
    const u16* K = p.kb + (size_t)(b * 4 + hd) * SALL * 64;
    const u16* V = p.vtb + (size_t)(b * 4 + hd) * 64 * SALL;
    int r0 = rp * 2;
    int rs0 = min(max(r0 - 4, 0), 56), rs1 = min(max(r0 + 1 - 4, 0), 56);
    attn_item<1>(p, Q, K, V, (rs1 + 8 - rs0) + 4, b * SEQ + rp * 128, 256 + hd * 64, rp, p.na_rpb + (size_t)(layer * 4 + hd) * 465, smem);
  } else if (it < 1056) {
    int i2 = it - 1024;
    int b = i2 >> 3, hd = (i2 >> 1) & 3, hf = i2 & 1;
    const u16* Q = p.qc + ((size_t)(b * 4 + hd) * SALL + hf * 128) * 64;
    const u16* K = p.kc + (size_t)(b * 2 + (hd >> 1)) * SALL * 64;
    const u16* V = p.vtc + (size_t)(b * 2 + (hd >> 1)) * 64 * SALL;
    attn_item<0>(p, Q, K, V, 4, NLAT + b * CTXL + hf * 128, 512 + hd * 64, 0, nullptr, smem);
  } else {
    int i2 = it - 1056;
    int b = i2 >> 3, hd = (i2 >> 1) & 3, hf = i2 & 1;
    const u16* Q = p.qb + ((size_t)(b * 4 + hd) * SALL + hf * 128) * 64;
    const u16* K = p.kb + (size_t)(b * 4 + hd) * SALL * 64;
    const u16* V = p.vtb + (size_t)(b * 4 + hd) * 64 * SALL;
    attn_item<0>(p, Q, K, V, 4, NLAT + b * CTXL + hf * 128, 256 + hd * 64, 0, nullptr, smem);
  }
}
constexpr int N_ATT_ITEMS = 1088;

DI void readout_tile(const Params& p, int layer, int t, char* smem) {
  const int tid = TID(), wv = tid >> 6;
  const int m0 = t * PTOK;
  float* sg = (float*)smem;
  for (int i = tid; i < PTOK * 64; i += 256) {
    int tok = i >> 6, k = i & 63;
    float v = p.pa[(size_t)(m0 + tok) * PAW + 896 + k];
    sg[i] = fsigmoid(v);
  }
  float g2r[64];
  const float* gq = launder(p.rw_g2 + (size_t)(layer * 64) * 256 + tid);
#pragma unroll
  for (int k = 0; k < 64; ++k) g2r[k] = gq[k * 256];
  const float gnw = p.rw_gnw[layer * 256 + tid], gnb = p.rw_gnb[layer * 256 + tid];
  __syncthreads();
#pragma unroll 1
  for (int tok = 0; tok < PTOK; ++tok) {
    const size_t m = (size_t)(m0 + tok);
    const float y = p.yf[m * 256 + tid] + p.yb[m * 256 + tid];
    const float mu = wave_sum(y) * (1.f / 64.f);
    const float d = y - mu;
    const float var = wave_sum(d * d) * (1.f / 64.f);
    const float yn = d * rsqrtf(var + 6.4e-4f) * gnw + gnb;
    const float bonus = p.bon[m * 4 + wv] * p.pa[m * PAW + 512 + tid];
    const float4* s4 = (const float4*)(sg + tok * 64);
    float gate = 0.f;
#pragma unroll
    for (int k4 = 0; k4 < 16; ++k4) {
      float4 sv = s4[k4];
      gate += sv.x * g2r[4 * k4] + sv.y * g2r[4 * k4 + 1] + sv.z * g2r[4 * k4 + 2] + sv.w * g2r[4 * k4 + 3];
    }
    p.hm[m * DM + tid] = (u16)(pack2((yn + bonus) * gate, 0.f) & 0xffff);
  }
  __syncthreads();
}

DI void final_tile(const Params& p, int t) {
  const int tid_ = TID(); const int wv = tid_ >> 6, lane = tid_ & 63;
  float* xa = p.out + (size_t)(t * 8 + wv * 2) * DM;
  float* xb = xa + DM;
  float4 va[4], vb[4], g4[4];
#pragma unroll
  for (int j = 0; j < 4; ++j) { va[j] = ((const float4*)xa)[lane + 64 * j]; vb[j] = ((const float4*)xb)[lane + 64 * j]; g4[j] = ((const float4*)p.final_g)[lane + 64 * j]; }
  float ssa = 0.f, ssb = 0.f;
#pragma unroll
  for (int j = 0; j < 4; ++j) {
    ssa += va[j].x * va[j].x + va[j].y * va[j].y + va[j].z * va[j].z + va[j].w * va[j].w;
    ssb += vb[j].x * vb[j].x + vb[j].y * vb[j].y + vb[j].z * vb[j].z + vb[j].w * vb[j].w;
  }
  ssa = wave_sum(ssa);
  ssb = wave_sum(ssb);
  const float ra = rsqrtf(ssa * (1.f / 1024.f) + 1e-6f), rb = rsqrtf(ssb * (1.f / 1024.f) + 1e-6f);
#pragma unroll
  for (int j = 0; j < 4; ++j) {
    ((float4*)xa)[lane + 64 * j] = make_float4(va[j].x * ra * g4[j].x, va[j].y * ra * g4[j].y, va[j].z * ra * g4[j].z, va[j].w * ra * g4[j].w);
    ((float4*)xb)[lane + 64 * j] = make_float4(vb[j].x * rb * g4[j].x, vb[j].y * rb * g4[j].y, vb[j].z * rb * g4[j].z, vb[j].w * rb * g4[j].w);
  }
}

constexpr int NSCAN = 32 * (16 / KPL);
DI void convert_dispatch(const Params& p, int wl, int t, char* smem) {
  const size_t ws = (size_t)(wl & 1) * WSET;
  if (t < 640) convert_tile(p.w_in + (size_t)wl * DM * DIN, p.win + ws, DM, DIN, t / 40, t % 40, smem);
  else if (t < 896) { int u = t - 640; convert_tile(p.w_out + (size_t)wl * DM * DM, p.wout + ws, DM, DM, u / 16, u % 16, smem); }
  else if (t < 1920) { int u = t - 896; convert_tile(p.mlp_w1 + (size_t)wl * DM * DFF, p.w1 + ws, DM, DFF, u / 64, u % 64, smem); }
  else { int u = t - 1920; convert_tile(p.mlp_w2 + (size_t)wl * DFF * DM, p.w2 + ws, DFF, DM, u / 16, u % 16, smem); }
}
DI void sub_barrier(unsigned* ctr, unsigned expected) {
  asm volatile("s_waitcnt vmcnt(0)" ::: "memory");
  __syncthreads();
  if (threadIdx.x == 0) {
    __builtin_amdgcn_fence(__ATOMIC_RELEASE, "agent");
    asm volatile("s_waitcnt vmcnt(0)" ::: "memory");
    xb_add(ctr, 1u);
    unsigned sp = 0;
    while (xb_ld(ctr) < expected) { __builtin_amdgcn_s_sleep(1); if (++sp > (1u << 22)) break; }
    __builtin_amdgcn_fence(__ATOMIC_ACQUIRE, "agent");
    asm volatile("s_waitcnt vmcnt(0)" ::: "memory");
  }
  __syncthreads();
}
template <int PH>
DI void run_phase(const Params& p, int layer, char* smem, int role = -1, int ridx = 0) {
  const int bid = blockIdx.x, nb = gridDim.x;
  const size_t ws = (size_t)(layer & 1) * WSET;
  const bool last = (layer == DEPTH - 1);
  const int mtiles = last ? 128 : 136;
  if (PH == 0) {
    for (int t = bid; t < 385; t += nb) setup_tile(p, t, smem);
  } else if (PH == 1) {
    const int nconv = (layer == 0) ? 2944 : 0;
    for (int t = bid; t < nconv + 2176; t += nb) {
      if (t < nconv) convert_dispatch(p, layer, t, smem);
      else norm_tile(p, layer, 0, t - nconv);
    }
  } else if (PH == 2) {
    for (int t = bid; t < 136 * 20; t += nb) gemm_tile<0>(p, layer, p.hm + (size_t)(t / 20) * 128 * DM, DM, 64, p.win + ws, DM, 16, t / 20, t % 20, smem);
  } else if (PH == 3) {
    for (int t = bid; t < 512 + 272; t += nb) {
      if (t < 512) rwkv_prep_tile(p, layer, t, smem);
      else attn_prep_tile(p, layer, t - 512, smem);
    }
  } else if (PH == 4) {
    const bool is_scan = (role >= 0) ? (role == 0) : (bid < NSCAN);
    const bool is_partner = (role == 1);
    const int nconv = (layer + 1 < DEPTH) ? 2944 : 0;
    if (is_scan) {
      scan_item(p, layer, (role >= 0) ? ridx : bid, smem);
    } else if (is_partner) {
      for (int it = ridx; it < nconv; it += NSCAN) convert_dispatch(p, layer + 1, it, smem);
    } else {
      const int ab = (role >= 0) ? ridx : bid - NSCAN, nab = (role >= 0) ? 256 : nb - NSCAN;
      const int total = N_ATT_ITEMS + 272 + ((role >= 0) ? 0 : nconv);
      for (int it = ab; it < total; it += nab) {
        if (it < N_ATT_ITEMS) { if (!(last && it >= 1024)) attn_dispatch(p, layer, it, smem); }
        else if (it < N_ATT_ITEMS + 272) { if (!(last && it - N_ATT_ITEMS >= 256)) pool_tile(p, layer, it - N_ATT_ITEMS, smem); }
        else convert_dispatch(p, layer + 1, it - N_ATT_ITEMS - 272, smem);
      }
    }
  } else if (PH == 5) {
    for (int t = bid; t < (last ? 482 : 512); t += nb) readout_tile(p, layer, t, smem);
  } else if (PH == 6) {
    for (int t = bid; t < mtiles * 8; t += nb) gemm_tile<1>(p, layer, p.hm + (size_t)(t / 8) * 128 * DM, DM, 64, p.wout + ws, DM, 16, t / 8, t % 8, smem);
  } else if (PH == 7) {
    for (int t = bid; t < mtiles * 16; t += nb) norm_tile(p, layer, 1, t);
  } else if (PH == 8) {
    for (int t = bid; t < mtiles * 32; t += nb) gemm_tile<2>(p, layer, p.hm + (size_t)(t / 32) * 128 * DM, DM, 64, p.w1 + ws, DM, 16, t / 32, t % 32, smem);
  } else if (PH == 9) {
    const int nfull = (nb == 512) ? 1024 : mtiles * 8;
    for (int t = bid; t < nfull; t += nb)
      gemm_tile<3>(p, layer, p.u + (size_t)(t / 8) * 64 * 8192, 64, 8192, p.w2 + ws, DFF, 64, t / 8, t % 8, smem);
    if (nfull < mtiles * 8) {
      const int t = 1024 + (bid >> 3), kp = bid & 7;
      gemm_tile<4>(p, layer, p.u + ((size_t)(t / 8) * 64 + kp * 8) * 8192, 64, 8192, p.w2 + ws + kp * 512, DFF, 8, t / 8, t % 8, smem);
    }
  } else if (PH == 10) {
    for (int t = bid; t < 2048; t += nb) final_tile(p, t);
  }
}

#define CEN_OFF (XCD_BAR_WORDS + 512)
#define CEN_WORDS 8704
__global__ void __launch_bounds__(256, 2) mega_kernel(Params p) {
  __shared__ __attribute__((aligned(16))) char smem[SMEM_BYTES];
  __shared__ uint4 xb_words;
  __shared__ int role_words[4];
  cg::grid_group grid = cg::this_grid();
  unsigned* cen = p.bar + CEN_OFF;
  unsigned key = 0, slot = 0;
  if (threadIdx.x == 0) {
    xb_words = make_uint4(0u, 0u, 0u, 0u);
    const unsigned hwid = (unsigned)__builtin_amdgcn_s_getreg((31 << 11) | 4);
    key = ((xb_xcc_id() & 15u) << 8) | (((hwid >> 13) & 7u) << 5) | (((hwid >> 12) & 1u) << 4) | ((hwid >> 8) & 15u);
    slot = xb_add(&cen[key], 1u);
    if (slot == 0u) { const unsigned r = xb_add(&cen[4096], 1u); __hip_atomic_store(&cen[4100 + key], r, __ATOMIC_RELAXED, __HIP_MEMORY_SCOPE_AGENT); }
  }
  __syncthreads();
  XcdBarrier xb = xcd_barrier_post(p.bar, (volatile LAS unsigned*)&xb_words);
  run_phase<0>(p, 0, smem);
  if (p.bar == nullptr) grid.sync();
  xcd_barrier(xb);
  if (threadIdx.x == 0 && xb_ld(&cen[key]) != 2u) xb_add(&cen[4097], 1u);
  int role = -1, ridx = 0;
#pragma unroll 1
  for (int layer = 0; layer < DEPTH; ++layer) {
    run_phase<1>(p, layer, smem); xcd_barrier(xb);
    if (layer == 0) {
      if (threadIdx.x == 0) {
        const unsigned bad = xb_ld(&cen[4097]), ncu = xb_ld(&cen[4096]), rank = xb_ld(&cen[4100 + key]);
        int r = -1, ri = 0;
        if (bad == 0u && gridDim.x == 512u && ncu == 256u && rank < 256u && slot < 2u) {
          if (rank < (unsigned)NSCAN) { r = (slot == 0u) ? 0 : 1; ri = (int)rank; }
          else { r = 2; ri = (int)(rank - NSCAN) * 2 + (int)slot; }
        }
        role_words[0] = r; role_words[1] = ri;
      }
      __syncthreads();
      role = role_words[0]; ridx = role_words[1];
    }
    run_phase<2>(p, layer, smem); xcd_barrier(xb);
    run_phase<3>(p, layer, smem); xcd_barrier(xb);
    run_phase<4>(p, layer, smem, role, ridx); xcd_barrier(xb);
    run_phase<5>(p, layer, smem); xcd_barrier(xb);
    run_phase<6>(p, layer, smem); xcd_barrier(xb);
    run_phase<7>(p, layer, smem); xcd_barrier(xb);
    run_phase<8>(p, layer, smem); xcd_barrier(xb);
    run_phase<9>(p, layer, smem); xcd_barrier(xb);
  }
  run_phase<10>(p, 0, smem);
}

extern "C" void kernel_launch(void* const* d_in, const int* in_sizes, int n_in, void* d_out, int out_size, void* d_ws, size_t ws_size,
                              hipStream_t stream) {
  Params p{};
  const float* const* in = (const float* const*)d_in;
  p.x = in[0]; p.c = in[1]; p.ctx = in[2]; p.c_ctx = in[3]; p.ada_w = in[4]; p.ada_b = in[5]; p.norm1_g = in[6]; p.norm2_g = in[7];
  p.w_in = in[8]; p.w_out = in[9]; p.rw_w0 = in[10]; p.rw_w2 = in[11]; p.rw_a0 = in[12]; p.rw_a2 = in[13]; p.rw_kk = in[14];
  p.rw_ka = in[15]; p.rw_rk = in[16]; p.rw_g2 = in[17]; p.rw_gnw = in[18]; p.rw_gnb = in[19]; p.na_rpb = in[20]; p.q_gain = in[21];
  p.k_gain = in[22]; p.pool_w = in[23]; p.pool_scale = in[24]; p.mlp_w1 = in[25]; p.mlp_w2 = in[26]; p.final_g = in[27];
  p.out = (float*)d_out;
  char* ws = (char*)d_ws;
  size_t off = 0;
  auto take = [&](size_t bytes) { char* r = ws + off; off += (bytes + 255) & ~(size_t)255; return r; };
  p.mod = (float*)take((size_t)DEPTH * 5 * 6144 * 4);
  p.rope = (float*)take(64 * 16 * 2 * 4);
  p.xc = (float*)take((size_t)NCTX * DM * 4);
  p.hm = (u16*)take((size_t)NTOK * DM * 2);
  p.win = (u16*)take(2 * WSET * 2);
  p.wout = p.win + (size_t)DINP * DM;
  p.w1 = p.wout + (size_t)DM * DM;
  p.w2 = p.w1 + (size_t)DFF * DM;
  p.yf = (float*)take((size_t)NTOK * 256 * 4);
  p.yb = (float*)take((size_t)NTOK * 256 * 4);
  p.qb = (u16*)take((size_t)NB * 4 * SALL * 64 * 2);
  p.kb = (u16*)take((size_t)NB * 4 * SALL * 64 * 2);
  p.vtb = (u16*)take((size_t)NB * 4 * SALL * 64 * 2);
  p.qc = (u16*)take((size_t)NB * 4 * SALL * 64 * 2);
  p.kc = (u16*)take((size_t)NB * 2 * SALL * 64 * 2);
  p.vtc = (u16*)take((size_t)NB * 2 * SALL * 64 * 2);
  char* big = ws + off;
  p.u = (u16*)big;
  p.pa = (float*)take((size_t)NTOK * PAW * 4);
  p.pb = (u16*)take((size_t)NTOK * PBW * 2);
  p.decf = (float*)take((size_t)NTOK * 256 * 4);
  p.decb = (float*)take((size_t)NTOK * 256 * 4);
  p.af = (float*)take((size_t)NTOK * 256 * 4);
  p.ab = (float*)take((size_t)NTOK * 256 * 4);
  p.kk = (float*)take((size_t)NTOK * 256 * 4);
  p.bon = (float*)take((size_t)NTOK * 4 * 4);
  p.bar = (unsigned*)take((XCD_BAR_WORDS + 512 + CEN_WORDS) * 4);
  if (off > ws_size) { fprintf(stderr, "workspace too small: need %zu have %zu\n", off, ws_size); return; }
  static int grid_blocks = 0;
  if (!grid_blocks) {
    int dev = 0, cus = 0, per_cu = 0;
    hipGetDevice(&dev);
    hipDeviceGetAttribute(&cus, hipDeviceAttributeMultiprocessorCount, dev);
    hipOccupancyMaxActiveBlocksPerMultiprocessor(&per_cu, mega_kernel, 256, 0);
    per_cu = 2;
    grid_blocks = cus * per_cu;
  }
  hipMemsetAsync(p.bar, 0, (XCD_BAR_WORDS + 512 + CEN_WORDS) * 4, stream);
  void* args[] = {&p};
  hipError_t e = hipLaunchCooperativeKernel((void*)mega_kernel, dim3(grid_blocks), dim3(256), args, 0, stream);
  if (e != hipSuccess) fprintf(stderr, "cooperative launch failed: %s (grid %d)\n", hipGetErrorString(e), grid_blocks);
}
```
